# Optimizing an MI355X kernel written in HIP

```python
import jax, jax.numpy as jnp
from jax import lax
import numpy as np

D_MODEL = 1024
BATCH = 4
SEQ = 4096
DEPTH = 4

RWKV_HEADS = 4
RWKV_HEAD_DIM = 64
RWKV_WIDTH = RWKV_HEADS * RWKV_HEAD_DIM
DECAY_LORA = 64
AAA_LORA = 64
GATE_LORA = 128
RWKV_LN_EPS = 64e-5

FOX_HEADS = 4
FOX_HEAD_DIM = 64
FOX_WIDTH = FOX_HEADS * FOX_HEAD_DIM

MLA_HEADS = 4
QK_NOPE_DIM = 128
QK_ROPE_DIM = 64
V_HEAD_DIM = 128
Q_LORA_RANK = 384
KV_LORA_RANK = 256
MLA_WIDTH = MLA_HEADS * V_HEAD_DIM
ROPE_THETA = 10000.0

N_BRANCHES = 3
D_FF = 4 * D_MODEL
Q_BLOCK = 128
NORM_EPS = 1e-6
MASK_VALUE = -1e30

RWKV_COLS = 3 * RWKV_WIDTH + DECAY_LORA + AAA_LORA + GATE_LORA
FOX_COLS = 3 * FOX_WIDTH + FOX_HEADS
MLA_COLS = Q_LORA_RANK + KV_LORA_RANK + QK_ROPE_DIM
GATE_COLS = N_BRANCHES * D_MODEL
IN_COLS = RWKV_COLS + FOX_COLS + MLA_COLS + GATE_COLS

kernel_name = 'hybrid_rwkv7_fox_mla_gated_decoder'


def rms_norm(x, gain, eps=NORM_EPS):
    xf = x.astype(jnp.float32)
    y = xf * lax.rsqrt(jnp.mean(xf * xf, axis=-1, keepdims=True) + eps)
    return y.astype(x.dtype) * gain


def token_shift(z):
    return jnp.pad(z, ((0, 0), (1, 0), (0, 0)))[:, :-1]


def apply_rope(x, cos, sin):
    x1, x2 = jnp.split(x, 2, axis=-1)
    return jnp.concatenate([x1 * cos - x2 * sin, x1 * sin + x2 * cos], axis=-1).astype(x.dtype)


def causal_block_attention(q, k, v, scale, log_forget_cum=None):
    B, S, H, _ = q.shape
    k_pos = jnp.arange(S)
    cum_bhs = None if log_forget_cum is None else jnp.transpose(log_forget_cum, (0, 2, 1))

    def one_block(i):
        start = i * Q_BLOCK
        qb = lax.dynamic_slice_in_dim(q, start, Q_BLOCK, axis=1)
        s = jnp.einsum('bqhd,bkhd->bhqk', qb, k, preferred_element_type=jnp.float32) * scale
        if cum_bhs is not None:
            cq = lax.dynamic_slice_in_dim(cum_bhs, start, Q_BLOCK, axis=2)
            s = s + cq[..., :, None] - cum_bhs[..., None, :]
        q_pos = start + jnp.arange(Q_BLOCK)
        s = jnp.where(k_pos[None, :] <= q_pos[:, None], s, MASK_VALUE)
        p = jax.nn.softmax(s, axis=-1).astype(v.dtype)
        return jnp.einsum('bhqk,bkhd->bqhd', p, v)

    out = lax.map(one_block, jnp.arange(S // Q_BLOCK))
    return jnp.moveaxis(out, 0, 1).reshape(B, S, H, v.shape[-1])


def rwkv7_mix(z, w0, w_decay_up, a0, w_aaa_up, w_gate_up, k_k, k_a, r_k, ln_g, ln_b):
    B, S, _ = z.shape
    offs = np.cumsum([RWKV_WIDTH, RWKV_WIDTH, RWKV_WIDTH, DECAY_LORA, AAA_LORA]).tolist()
    r, k, v, wd, ad, gd = jnp.split(z, offs, axis=-1)
    w_log = -jax.nn.softplus(-(w0 + jnp.tanh(wd) @ w_decay_up)) - 0.5
    decay = jnp.exp(-jnp.exp(w_log.astype(jnp.float32)))
    a = jax.nn.sigmoid(a0 + ad @ w_aaa_up)
    g = jax.nn.sigmoid(gd) @ w_gate_up
    kk = k * k_k
    k = k * (1 + (a - 1) * k_a)
    heads = lambda t: t.reshape(B, S, RWKV_HEADS, RWKV_HEAD_DIM).astype(jnp.float32)
    r_h, k_h, v_h, a_h, w_h, kk_h = map(heads, (r, k, v, a, decay, kk))
    kk_h = kk_h / jnp.maximum(jnp.linalg.norm(kk_h, axis=-1, keepdims=True), 1e-12)

    def step(state, inp):
        r_t, w_t, k_t, v_t, kk_t, a_t = inp
        sa = jnp.einsum('bhvk,bhk->bhv', state, -kk_t)
        state = (state * w_t[:, :, None, :] + sa[..., None] * (kk_t * a_t)[:, :, None, :]
                 + v_t[..., None] * k_t[:, :, None, :])
        return state, jnp.einsum('bhvk,bhk->bhv', state, r_t)

    state0 = jnp.zeros((B, RWKV_HEADS, RWKV_HEAD_DIM, RWKV_HEAD_DIM), jnp.float32)
    xs = tuple(jnp.moveaxis(t, 1, 0) for t in (r_h, w_h, k_h, v_h, kk_h, a_h))
    _, y = lax.scan(step, state0, xs)
    y = jnp.moveaxis(y, 0, 1)
    mean = jnp.mean(y, -1, keepdims=True)
    var = jnp.mean(jnp.square(y - mean), -1, keepdims=True)
    y = ((y - mean) * lax.rsqrt(var + RWKV_LN_EPS)).reshape(B, S, RWKV_WIDTH) * ln_g + ln_b
    bonus = jnp.sum(r_h * k_h * r_k, -1, keepdims=True) * v_h
    y = (y + bonus.reshape(B, S, RWKV_WIDTH)) * g
    return y.astype(z.dtype)


def fox_mix(z, b_forget):
    B, S, _ = z.shape
    q, k, v, f = jnp.split(z, [FOX_WIDTH, 2 * FOX_WIDTH, 3 * FOX_WIDTH], axis=-1)
    heads = lambda t: t.reshape(B, S, FOX_HEADS, FOX_HEAD_DIM)
    log_f = jax.nn.log_sigmoid((f + b_forget).astype(jnp.float32))
    cum = jnp.cumsum(log_f, axis=1)
    o = causal_block_attention(heads(q), heads(k), heads(v), FOX_HEAD_DIM ** -0.5, cum)
    return o.reshape(B, S, FOX_WIDTH)


def mla_mix(z, q_norm_g, w_q_up, kv_norm_g, w_kv_up, cos, sin):
    B, S, _ = z.shape
    q_lat, kv_lat, k_pe = jnp.split(z, [Q_LORA_RANK, Q_LORA_RANK + KV_LORA_RANK], axis=-1)
    q = (rms_norm(q_lat, q_norm_g) @ w_q_up).reshape(B, S, MLA_HEADS, QK_NOPE_DIM + QK_ROPE_DIM)
    kv = (rms_norm(kv_lat, kv_norm_g) @ w_kv_up).reshape(B, S, MLA_HEADS, QK_NOPE_DIM + V_HEAD_DIM)
    q_nope, q_pe = jnp.split(q, [QK_NOPE_DIM], axis=-1)
    k_nope, v = jnp.split(kv, [QK_NOPE_DIM], axis=-1)
    q_pe = apply_rope(q_pe, cos[:, :, None, :], sin[:, :, None, :])
    k_pe = apply_rope(k_pe, cos, sin)[:, :, None, :]
    q_full = jnp.concatenate([q_nope, q_pe], axis=-1)
    k_full = jnp.concatenate([k_nope, jnp.broadcast_to(k_pe, (B, S, MLA_HEADS, QK_ROPE_DIM))], axis=-1)
    o = causal_block_attention(q_full, k_full, v, (QK_NOPE_DIM + QK_ROPE_DIM) ** -0.5)
    return o.reshape(B, S, MLA_WIDTH)


def setup_inputs(seed: int = 0) -> dict:
    key = jax.random.key(seed)
    ks = iter(jax.random.split(key, 40))
    L, D = DEPTH, D_MODEL
    nrm = lambda shape, scale: jax.random.normal(next(ks), shape, jnp.float32) * scale
    gain = lambda shape: 1.0 + nrm(shape, 0.02)
    x = nrm((BATCH, SEQ, D), 1.0)
    c = nrm((BATCH, D), 1.0)
    positions = (jnp.arange(SEQ, dtype=jnp.int32)[None, :]
                 + jax.random.randint(next(ks), (BATCH, 1), 0, 1024, dtype=jnp.int32))
    return {
        'x': x, 'c': c, 'positions': positions,
        'w_in': nrm((L, D, IN_COLS), D ** -0.5),
        'mu_shift': jax.random.uniform(next(ks), (L, RWKV_COLS), jnp.float32),
        'w0': -1.0 + nrm((L, RWKV_WIDTH), 0.5),
        'w_decay_up': nrm((L, DECAY_LORA, RWKV_WIDTH), DECAY_LORA ** -0.5),
        'a0': nrm((L, RWKV_WIDTH), 0.1),
        'w_aaa_up': nrm((L, AAA_LORA, RWKV_WIDTH), AAA_LORA ** -0.5),
        'w_gate_up': nrm((L, GATE_LORA, RWKV_WIDTH), GATE_LORA ** -0.5),
        'k_k': 0.85 + nrm((L, RWKV_WIDTH), 0.05),
        'k_a': gain((L, RWKV_WIDTH)),
        'r_k': nrm((L, RWKV_HEADS, RWKV_HEAD_DIM), 0.1),
        'ln_x_g': gain((L, RWKV_WIDTH)),
        'ln_x_b': nrm((L, RWKV_WIDTH), 0.02),
        'b_forget': 2.0 + nrm((L, FOX_HEADS), 0.5),
        'q_norm_g': gain((L, Q_LORA_RANK)),
        'w_q_up': nrm((L, Q_LORA_RANK, MLA_HEADS * (QK_NOPE_DIM + QK_ROPE_DIM)), Q_LORA_RANK ** -0.5),
        'kv_norm_g': gain((L, KV_LORA_RANK)),
        'w_kv_up': nrm((L, KV_LORA_RANK, MLA_HEADS * (QK_NOPE_DIM + V_HEAD_DIM)), KV_LORA_RANK ** -0.5),
        'w_branch_a': nrm((L, RWKV_WIDTH, D), RWKV_WIDTH ** -0.5),
        'w_branch_b': nrm((L, FOX_WIDTH, D), FOX_WIDTH ** -0.5),
        'w_branch_c': nrm((L, MLA_WIDTH, D), MLA_WIDTH ** -0.5),
        'w_out': nrm((L, D, D), D ** -0.5),
        'w_mod': nrm((L, D, 6 * D), 0.5 * D ** -0.5),
        'b_mod': nrm((L, 6 * D), 0.02),
        'norm_mix_pre': gain((L, D)),
        'norm_mix_post': gain((L, D)),
        'norm_ffn_pre': gain((L, D)),
        'norm_ffn_post': gain((L, D)),
        'w_ffn_up': nrm((L, D, D_FF), D ** -0.5),
        'w_ffn_down': nrm((L, D_FF, D), D_FF ** -0.5),
    }


def reference(x, c, positions, w_in, mu_shift, w0, w_decay_up, a0, w_aaa_up, w_gate_up, k_k, k_a, r_k,
              ln_x_g, ln_x_b, b_forget, q_norm_g, w_q_up, kv_norm_g, w_kv_up, w_branch_a, w_branch_b,
              w_branch_c, w_out, w_mod, b_mod, norm_mix_pre, norm_mix_post, norm_ffn_pre, norm_ffn_post,
              w_ffn_up, w_ffn_down):
    B, S, D = x.shape
    inv_freq = ROPE_THETA ** (-jnp.arange(0, QK_ROPE_DIM, 2, dtype=jnp.float32) / QK_ROPE_DIM)
    ang = positions.astype(jnp.float32)[..., None] * inv_freq
    cos, sin = jnp.cos(ang), jnp.sin(ang)
    c_act = jax.nn.silu(c)
    split_cols = [RWKV_COLS, RWKV_COLS + FOX_COLS, RWKV_COLS + FOX_COLS + MLA_COLS]
    for l in range(DEPTH):
        mod = c_act @ w_mod[l] + b_mod[l]
        sh_m, sc_m, g_m, sh_f, sc_f, g_f = [m[:, None, :] for m in jnp.split(mod, 6, axis=-1)]

        h = rms_norm(x, norm_mix_pre[l]) * (1 + sc_m) + sh_m
        z = h @ w_in[l]
        z_a, z_b, z_c, z_g = jnp.split(z, split_cols, axis=-1)
        z_a = z_a + (token_shift(z_a) - z_a) * mu_shift[l]
        y_a = rwkv7_mix(z_a, w0[l], w_decay_up[l], a0[l], w_aaa_up[l], w_gate_up[l], k_k[l], k_a[l],
                        r_k[l], ln_x_g[l], ln_x_b[l])
        y_b = fox_mix(z_b, b_forget[l])
        y_c = mla_mix(z_c, q_norm_g[l], w_q_up[l], kv_norm_g[l], w_kv_up[l], cos, sin)
        gates = jax.nn.sigmoid(z_g).reshape(B, S, N_BRANCHES, D)
        merged = (gates[:, :, 0] * (y_a @ w_branch_a[l]) + gates[:, :, 1] * (y_b @ w_branch_b[l])
                  + gates[:, :, 2] * (y_c @ w_branch_c[l]))
        x = x + g_m * rms_norm(merged @ w_out[l], norm_mix_post[l])

        h = rms_norm(x, norm_ffn_pre[l]) * (1 + sc_f) + sh_f
        u = jnp.square(jax.nn.relu(h @ w_ffn_up[l]))
        x = x + g_f * rms_norm(u @ w_ffn_down[l], norm_ffn_post[l])
    return x
```

```cpp
#include <hip/hip_runtime.h>
#include <hip/hip_cooperative_groups.h>
#include <stdint.h>
#include <stdio.h>
namespace cg = cooperative_groups;

#define DI __device__ __forceinline__
#define LAS __attribute__((address_space(3)))
typedef unsigned short u16;
typedef __attribute__((ext_vector_type(8))) short bf16x8;
typedef __attribute__((ext_vector_type(4))) short s16x4;
typedef __attribute__((ext_vector_type(4))) float f32x4;
typedef __attribute__((ext_vector_type(16))) float f32x16;
typedef __attribute__((ext_vector_type(2))) float f32v2;
typedef __attribute__((ext_vector_type(2))) __bf16 bf16v2;

constexpr int T = 16384;
constexpr int SEQ = 4096;
constexpr int INP = 5632;
constexpr int NTHR = 512;
constexpr int LDS_BYTES = 147456;
constexpr int LDS_MISC = 131072;

constexpr size_t OFF_CTL  = 0;
constexpr size_t OFF_MODP = 65536;
constexpr size_t OFF_MOD  = OFF_MODP + 8ull * 4 * 4 * 6144 * 4;
constexpr size_t OFF_COS  = OFF_MOD + 4ull * 4 * 6144 * 4;
constexpr size_t OFF_SIN  = OFF_COS + (size_t)T * 32 * 4;
constexpr size_t OFF_FLOG = OFF_SIN + (size_t)T * 32 * 4;
constexpr size_t OFF_CUM  = OFF_FLOG + (size_t)T * 4 * 4;
constexpr size_t OFF_INVN = OFF_CUM + 16ull * 4096 * 4;
constexpr size_t OFF_WIN  = OFF_INVN + (size_t)T * 4 * 4;
constexpr size_t OFF_WQ   = OFF_WIN + (size_t)INP * 1024 * 2;
constexpr size_t OFF_WKV  = OFF_WQ + 768ull * 384 * 2;
constexpr size_t OFF_WA   = OFF_WKV + 1024ull * 256 * 2;
constexpr size_t OFF_WB   = OFF_WA + 1024ull * 256 * 2;
constexpr size_t OFF_WC   = OFF_WB + 1024ull * 256 * 2;
constexpr size_t OFF_WOUT = OFF_WC + 1024ull * 512 * 2;
constexpr size_t OFF_WUP  = OFF_WOUT + 1024ull * 1024 * 2;
constexpr size_t OFF_WDN  = OFF_WUP + 4096ull * 1024 * 2;
constexpr size_t OFF_WLORA = OFF_WDN + 4096ull * 1024 * 2;
constexpr size_t OFF_ACT  = OFF_WLORA + 768ull * 256 * 2;
constexpr size_t OFF_GATES = OFF_ACT;
constexpr size_t OFF_ZRAW  = OFF_GATES + (size_t)T * 3072 * 2;
constexpr size_t OFF_UBUF  = OFF_GATES;
constexpr size_t OFF_Z2    = OFF_ZRAW + (size_t)T * 1024 * 2;
constexpr size_t OFF_ZQ    = OFF_Z2;
constexpr size_t OFF_ZKV   = OFF_ZQ + (size_t)T * 384 * 2;
constexpr size_t OFF_ZPE   = OFF_ZKV + (size_t)T * 256 * 2;
constexpr size_t OFF_ZK    = OFF_ZPE + (size_t)T * 64 * 2;
constexpr size_t OFF_ZL    = OFF_ZK + (size_t)T * 256 * 4;
constexpr size_t OFF_Z2END = OFF_ZL + (size_t)T * 256 * 2;
constexpr size_t OFF_Y     = OFF_ZRAW;
constexpr size_t OFF_YB    = OFF_Y + (size_t)T * 256 * 4;
constexpr size_t OFF_YA    = OFF_YB + (size_t)T * 256 * 2;
constexpr size_t OFF_YC    = OFF_Z2END;
constexpr size_t OFF_RS   = OFF_YC + (size_t)T * 512 * 2;
constexpr size_t OFF_SR   = OFF_RS;
constexpr size_t OFF_SKP  = OFF_SR + (size_t)T * 256 * 2;
constexpr size_t OFF_SKK  = OFF_SKP + (size_t)T * 256 * 2;
constexpr size_t OFF_SKKA = OFF_SKK + (size_t)T * 256 * 2;
constexpr size_t OFF_SV   = OFF_SKKA + (size_t)T * 256 * 2;
constexpr size_t OFF_SW   = OFF_SV + (size_t)T * 256 * 2;
constexpr size_t OFF_SG   = OFF_SW + (size_t)T * 256 * 4;
constexpr size_t OFF_TMP  = OFF_RS;
constexpr size_t OFF_TBUF = OFF_RS;
constexpr size_t OFF_RM   = OFF_SG + (size_t)T * 256 * 2;
constexpr size_t OFF_MQ   = OFF_RM;
constexpr size_t OFF_MK   = OFF_MQ + (size_t)T * 768 * 2;
constexpr size_t OFF_MVT  = OFF_MK + (size_t)T * 768 * 2;
constexpr size_t OFF_FQ   = OFF_MVT + (size_t)T * 512 * 2;
constexpr size_t OFF_FK   = OFF_FQ + (size_t)T * 256 * 2;
constexpr size_t OFF_FVT  = OFF_FK + (size_t)T * 256 * 2;
constexpr size_t OFF_MERGED = OFF_RM;
constexpr size_t OFF_HBUF = OFF_RM;
constexpr size_t WS_END   = OFF_FVT + (size_t)T * 256 * 2;

struct Params { const void* in[32]; float* out; unsigned char* ws; };

DI int otid_(int wid) { int l; asm volatile("v_mbcnt_lo_u32_b32 %0, -1, 0\n\tv_mbcnt_hi_u32_b32 %0, -1, %0" : "=v"(l)); return (wid << 6) | l; }
#define otid() otid_(wid_k)
DI float bflo(unsigned u) { return __uint_as_float(u << 16); }
DI float bfhi(unsigned u) { return __uint_as_float(u & 0xffff0000u); }
DI unsigned pack2(float a, float b) { f32v2 v = {a, b}; bf16v2 r = __builtin_convertvector(v, bf16v2); return __builtin_bit_cast(unsigned, r); }
DI u16 f2bf(float a) { return (u16)(pack2(a, 0.f) & 0xffffu); }
DI uint2 pack4(f32x4 v) { uint2 r; r.x = pack2(v[0], v[1]); r.y = pack2(v[2], v[3]); return r; }
DI uint4 pack8(f32x4 a, f32x4 b) { uint4 r; r.x = pack2(a[0], a[1]); r.y = pack2(a[2], a[3]); r.z = pack2(b[0], b[1]); r.w = pack2(b[2], b[3]); return r; }
DI f32x4 unpack4(uint2 u) { f32x4 r; r[0] = bflo(u.x); r[1] = bfhi(u.x); r[2] = bflo(u.y); r[3] = bfhi(u.y); return r; }
DI float sigmoidf_(float x) { return 1.f / (1.f + __expf(-x)); }
DI float softplusf_(float x) { return fmaxf(x, 0.f) + log1pf(__expf(-fabsf(x))); }
template <int CTRL> DI float dpp_add(float v) {
  int t = __builtin_amdgcn_update_dpp(0, __float_as_int(v), CTRL, 0xF, 0xF, true);
  return v + __int_as_float(t);
}
DI float reduce16(float v) {
  v = dpp_add<0xB1>(v);
  v = dpp_add<0x4E>(v);
  v = dpp_add<0x141>(v);
  v = dpp_add<0x140>(v);
  return v;
}

DI float wave_sum(float v) {
  v = reduce16(v);
  { auto r = __builtin_amdgcn_permlane16_swap(__float_as_uint(v), __float_as_uint(v), false, false); v = __uint_as_float(r[0]) + __uint_as_float(r[1]); }
  { auto r = __builtin_amdgcn_permlane32_swap(__float_as_uint(v), __float_as_uint(v), false, false); v = __uint_as_float(r[0]) + __uint_as_float(r[1]); }
  return v;
}
namespace pg8 {
constexpr int BM = 256, BK = 64, HALF = 128, HTB = HALF * BK * 2, NXCD = 8, WGM = 8;
DI int lds_byte(int r, int c) { const int st = (r >> 4) * 2 + (c >> 5), rr = r & 15, cc = c & 31, ob = rr * 64 + cc * 2; return st * 1024 + (ob ^ (((ob >> 9) & 1) << 5)); }
DI void stage_rc(int b, int& R, int& C) { const int st = b / 1024, sb = b % 1024, swz = sb ^ (((sb >> 9) & 1) << 5); R = (st >> 1) * 16 + swz / 64; C = (st & 1) * 32 + (swz % 64) / 2; }
DI int perm32(int rho) { const int n = rho >> 4, i = rho & 15; return 8 * (i >> 2) + 4 * n + (i & 3); }
struct Unit { int pm, pn; };
struct Gemm { const u16* A; const u16* Bt; int lda, N, K; };
struct StaticOrder {
  int nM, nN, nwg, G, c;
  DI void init(int M, int N, int G_, int c_) { nM = M / BM; nN = N / BM; nwg = nM * nN; G = G_; c = c_; }
  DI bool next(int i, Unit& u) const {
    const long L = (long)i * G + c; if (L >= nwg) return false;
    int wgid = (int)L; { const int q = nwg / NXCD, r = nwg % NXCD, xcd = wgid % NXCD, off = wgid / NXCD; wgid = (xcd < r ? xcd * (q + 1) : r * (q + 1) + (xcd - r) * q) + off; }
    const int nig = WGM * nN, gid = wgid / nig, fm = gid * WGM, gsz = (nM - fm) < WGM ? (nM - fm) : WGM;
    u.pm = fm + ((wgid % nig) % gsz); u.pn = (wgid % nig) / gsz; return true;
  }
};

struct OneUnit { int pm, pn, valid; DI bool next(int i, Unit& u) const { if (i != 0 || !valid) return false; u.pm = pm; u.pn = pn; return true; } };
template <class Epi, class Sched>
DI void gemm_phase(LAS unsigned char* lds, const Gemm g, const Sched& S, const Epi& E, int wid_k) {
  const int tid = otid(), wid = __builtin_amdgcn_readfirstlane(tid >> 6), lane = tid & 63, wr = wid >> 2, wc = wid & 3, fr = lane & 15, fq = lane >> 4;
  const int K = g.K, nt = K / BK;
  unsigned voffA[2], voffB[2];
#pragma unroll
  for (int i = 0; i < 2; ++i) { int R, C; stage_rc(tid * 16 + i * 8192, R, C); const int Rb = (R & ~31) + perm32(R & 31);
    voffA[i] = (unsigned)(R * g.lda + C) * 2u; voffB[i] = (unsigned)(Rb * K + C) * 2u; }
  const size_t kstep = (size_t)(BK * 2);
  const size_t hstepA = (size_t)HALF * g.lda * 2, hstepB = (size_t)HALF * K * 2;
  const size_t tstepA = 2 * hstepA, tstepB = 2 * hstepB;
  const unsigned ldsw = (unsigned)wid * 1024u;
  const int aoff = lds_byte(wr * 64 + fr, fq * 8), boff = lds_byte(wc * 32 + fr, fq * 8);
#define PG8_SA(b, h) (((b) * 2 + (h)) * HTB)
#define PG8_SB(b, h) ((4 + (b) * 2 + (h)) * HTB)
#define PG8_STAGE(bufoff, gbase, voff) do { _Pragma("unroll") for (int _i = 0; _i < 2; ++_i) \
    __builtin_amdgcn_global_load_lds((const unsigned*)((const char*)(gbase) + (voff)[_i]), (LAS unsigned*)(lds + (bufoff) + ldsw + _i * 8192), 16, 0, 0); } while (0)
#define PG8_LDA(dst, b, h) do { _Pragma("unroll") for (int m = 0; m < 4; ++m) _Pragma("unroll") for (int k = 0; k < 2; ++k) dst[m][k] = *(const LAS bf16x8*)(lds + PG8_SA(b, h) + aoff + m * 2048 + k * 1024); } while (0)
#define PG8_LDB(dst, b, h) do { _Pragma("unroll") for (int n = 0; n < 2; ++n) _Pragma("unroll") for (int k = 0; k < 2; ++k) dst[n][k] = *(const LAS bf16x8*)(lds + PG8_SB(b, h) + boff + n * 2048 + k * 1024); } while (0)
#define PG8_MMA(ai, bj, At, Bt) do { __builtin_amdgcn_s_setprio(1); _Pragma("unroll") for (int m = 0; m < 4; ++m) _Pragma("unroll") for (int n = 0; n < 2; ++n) _Pragma("unroll") for (int k = 0; k < 2; ++k) \
    acc[ai][bj][m][n] = __builtin_amdgcn_mfma_f32_16x16x32_bf16(Bt[n][k], At[m][k], acc[ai][bj][m][n], 0, 0, 0); __builtin_amdgcn_s_setprio(0); } while (0)
#define PG8_WAIT_V(n) asm volatile("s_waitcnt vmcnt(" #n ")" ::: "memory")
#define PG8_WAIT_L(n) asm volatile("s_waitcnt lgkmcnt(" #n ")" ::: "memory")
#define PG8_BAR __builtin_amdgcn_s_barrier()
#define PG8_SCHED __builtin_amdgcn_sched_barrier(0)
  Unit cur, nxt; int ui = 0;
  if (!S.next(0, cur)) return;
  f32x4 acc[2][2][4][2];
#pragma unroll
  for (int a = 0; a < 2; ++a)
#pragma unroll
    for (int b = 0; b < 2; ++b)
#pragma unroll
      for (int m = 0; m < 4; ++m)
#pragma unroll
        for (int n = 0; n < 2; ++n) acc[a][b][m][n] = (f32x4){0.f, 0.f, 0.f, 0.f};
  bf16x8 At[4][2], B0[2][2], B1[2][2];
  const char* cA = (const char*)g.A + (size_t)cur.pm * tstepA; const char* cB = (const char*)g.Bt + (size_t)cur.pn * tstepB;
  PG8_STAGE(PG8_SB(0, 0), cB, voffB); PG8_STAGE(PG8_SA(0, 0), cA, voffA); PG8_STAGE(PG8_SB(0, 1), cB + hstepB, voffB); PG8_STAGE(PG8_SA(0, 1), cA + hstepA, voffA);
  if (wr == 1) PG8_BAR;
  PG8_WAIT_V(4); PG8_BAR;
  PG8_STAGE(PG8_SB(1, 0), cB + kstep, voffB); PG8_STAGE(PG8_SA(1, 0), cA + kstep, voffA); PG8_STAGE(PG8_SB(1, 1), cB + hstepB + kstep, voffB);
  PG8_WAIT_V(6); PG8_BAR;
  for (;;) {
    const bool has_next = S.next(ui + 1, nxt);
    const char* nA = has_next ? (const char*)g.A + (size_t)nxt.pm * tstepA : cA; const char* nB = has_next ? (const char*)g.Bt + (size_t)nxt.pn * tstepB : cB;
    for (int t = 0; t < nt; t += 2) {
      const bool last = (t == nt - 2);
      const char* a1 = cA + (size_t)(t + 1) * kstep;
      const char* a2 = last ? nA : cA + (size_t)(t + 2) * kstep; const char* b2 = last ? nB : cB + (size_t)(t + 2) * kstep;
      const char* a3 = a2 + kstep; const char* b3 = b2 + kstep;
      PG8_LDB(B0, 0, 0); PG8_SCHED; PG8_LDA(At, 0, 0); PG8_STAGE(PG8_SA(1, 1), a1 + hstepA, voffA);
      PG8_WAIT_L(8); PG8_BAR; PG8_WAIT_L(0); PG8_MMA(0, 0, At, B0); PG8_BAR; PG8_SCHED;
      PG8_LDB(B1, 0, 1); PG8_STAGE(PG8_SB(0, 0), b2, voffB);
      PG8_BAR; PG8_WAIT_L(0); PG8_MMA(0, 1, At, B1); PG8_BAR;
      PG8_LDA(At, 0, 1); PG8_STAGE(PG8_SA(0, 0), a2, voffA);
      PG8_BAR; PG8_WAIT_L(0); PG8_MMA(1, 0, At, B0); PG8_BAR; PG8_SCHED;
      PG8_STAGE(PG8_SB(0, 1), b2 + hstepB, voffB);
      PG8_WAIT_V(6); PG8_BAR; PG8_MMA(1, 1, At, B1); PG8_BAR;
      PG8_LDB(B0, 1, 0); PG8_SCHED; PG8_LDA(At, 1, 0); PG8_STAGE(PG8_SA(0, 1), a2 + hstepA, voffA);
      PG8_WAIT_L(8); PG8_BAR; PG8_WAIT_L(0); PG8_MMA(0, 0, At, B0); PG8_BAR; PG8_SCHED;
      PG8_LDB(B1, 1, 1); PG8_STAGE(PG8_SB(1, 0), b3, voffB);
      PG8_BAR; PG8_WAIT_L(0); PG8_MMA(0, 1, At, B1); PG8_BAR;
      PG8_LDA(At, 1, 1); PG8_STAGE(PG8_SA(1, 0), a3, voffA);
      PG8_BAR; PG8_WAIT_L(0); PG8_MMA(1, 0, At, B0); PG8_BAR; PG8_SCHED;
      PG8_STAGE(PG8_SB(1, 1), b3 + hstepB, voffB);
      PG8_WAIT_V(6); PG8_BAR; PG8_MMA(1, 1, At, B1); PG8_BAR;
    }
    { int fr_ = fr, fq_ = fq, wr_ = wr, wc_ = wc; asm volatile("" : "+v"(fr_), "+v"(fq_)); asm volatile("" : "+s"(wr_), "+s"(wc_)); E(acc, cur, wr_, wc_, fr_, fq_); }
    if (!has_next) break;
#pragma unroll
    for (int a = 0; a < 2; ++a)
#pragma unroll
      for (int b = 0; b < 2; ++b)
#pragma unroll
        for (int m = 0; m < 4; ++m)
#pragma unroll
          for (int n = 0; n < 2; ++n) acc[a][b][m][n] = (f32x4){0.f, 0.f, 0.f, 0.f};
    cur = nxt; cA = nA; cB = nB; ++ui;
  }
  PG8_WAIT_V(0);
  if (wr == 0) PG8_BAR;
  PG8_BAR;
#undef PG8_SA
#undef PG8_SB
#undef PG8_STAGE
#undef PG8_LDA
#undef PG8_LDB
#undef PG8_MMA
#undef PG8_WAIT_V
#undef PG8_WAIT_L
#undef PG8_BAR
#undef PG8_SCHED
}
}
typedef f32x4 Acc8[2][2][4][2];
#define EPI_ROWS(ai, m) (u.pm * 256 + (ai) * 128 + wr * 64 + (m) * 16 + fr)
#define EPI_COL8(bj) (u.pn * 256 + (bj) * 128 + wc * 32 + 8 * fq)

struct EpiInProj {
  u16 *zraw, *fq_, *fk_, *fvT, *zq, *zkv, *zpe, *gates; float* flog; const float* b_forget; int coff;
  DI void operator()(const Acc8& acc, const pg8::Unit& u, int wr, int wc, int fr, int fq) const {
#pragma unroll
    for (int bj = 0; bj < 2; ++bj) {
      const int c32 = coff + u.pn * 256 + bj * 128 + wc * 32;
      const int c8 = c32 + 8 * fq;
#pragma unroll
      for (int ai = 0; ai < 2; ++ai)
#pragma unroll
        for (int m = 0; m < 4; ++m) {
          const int row = EPI_ROWS(ai, m); const int b = row >> 12, s = row & 4095;
          f32x4 v0 = acc[ai][bj][m][0], v1 = acc[ai][bj][m][1];
          if (c32 < 1024) { *(uint4*)(zraw + (size_t)row * 1024 + c8) = pack8(v0, v1); }
          else if (c32 < 1792) {
            const int c = c8 - 1024, part = c >> 8, hc = c & 255, h = hc >> 6, d = hc & 63; const size_t bh = (size_t)b * 4 + h;
            if (part == 0) { v0 *= 0.18033688f; v1 *= 0.18033688f; *(uint4*)(fq_ + (bh * SEQ + s) * 64 + d) = pack8(v0, v1); }
            else if (part == 1) { *(uint4*)(fk_ + (bh * SEQ + s) * 64 + d) = pack8(v0, v1); }
            else {
#pragma unroll
              for (int e = 0; e < 4; ++e) { fvT[(bh * 64 + d + e) * SEQ + s] = f2bf(v0[e]); fvT[(bh * 64 + d + 4 + e) * SEQ + s] = f2bf(v1[e]); }
            }
          }
          else if (c32 < 2176) { *(uint4*)(zq + (size_t)row * 384 + (c8 - 1792)) = pack8(v0, v1); }
          else if (c32 < 2432) { *(uint4*)(zkv + (size_t)row * 256 + (c8 - 2176)) = pack8(v0, v1); }
          else if (c32 < 2496) { *(uint4*)(zpe + (size_t)row * 64 + (c8 - 2432)) = pack8(v0, v1); }
          else if (c32 < 2560) {
            if (c8 == 2496) {
              float4 lf;
              { const float x = v0[0] + b_forget[0]; lf.x = fminf(x, 0.f) - log1pf(__expf(-fabsf(x))); }
              { const float x = v0[1] + b_forget[1]; lf.y = fminf(x, 0.f) - log1pf(__expf(-fabsf(x))); }
              { const float x = v0[2] + b_forget[2]; lf.z = fminf(x, 0.f) - log1pf(__expf(-fabsf(x))); }
              { const float x = v0[3] + b_forget[3]; lf.w = fminf(x, 0.f) - log1pf(__expf(-fabsf(x))); }
              *(float4*)(flog + (size_t)row * 4) = lf;
            }
          }
          else {
#pragma unroll
            for (int e = 0; e < 4; ++e) { v0[e] = sigmoidf_(v0[e]); v1[e] = sigmoidf_(v1[e]); }
            *(uint4*)(gates + (size_t)row * 3072 + (c8 - 2560)) = pack8(v0, v1);
          }
        }
    }
  }
};
struct EpiKv {
  u16 *mk, *mvT; const float* rstd;
  DI void operator()(const Acc8& acc, const pg8::Unit& u, int wr, int wc, int fr, int fq) const {
    const int d0 = wc * 32 + 8 * fq;
#pragma unroll
    for (int ai = 0; ai < 2; ++ai)
#pragma unroll
      for (int m = 0; m < 4; ++m) {
        const int rl = ai * 128 + wr * 64 + m * 16 + fr; const int row = u.pm * 256 + rl; const int b = row >> 12, s = row & 4095;
        const float rs = rstd[rl]; const unsigned bh = (unsigned)(b * 4 + u.pn);
        { f32x4 v0 = acc[ai][0][m][0], v1 = acc[ai][0][m][1]; v0 *= rs; v1 *= rs;
          *(uint4*)((char*)mk + ((bh * SEQ + s) * 192u + d0) * 2u) = pack8(v0, v1); }
        { f32x4 v0 = acc[ai][1][m][0], v1 = acc[ai][1][m][1]; v0 *= rs; v1 *= rs;
          const unsigned vo = ((bh * 128u + d0) * SEQ + s) * 2u;
#pragma unroll
          for (int e = 0; e < 4; ++e) { *(u16*)((char*)mvT + (vo + (unsigned)(e * (SEQ * 2)))) = f2bf(v0[e]); *(u16*)((char*)mvT + (vo + (unsigned)((4 + e) * (SEQ * 2)))) = f2bf(v1[e]); } }
        asm volatile("" ::: "memory"); __builtin_amdgcn_sched_barrier(0);
      }
  }
};
struct EpiQ {
  u16* mq; const float* rstd; const float *costab, *sintab;
  DI void operator()(const Acc8& acc, const pg8::Unit& u, int wr, int wc, int fr, int fq) const {
#pragma unroll
    for (int bj = 0; bj < 2; ++bj) {
      const int c8 = EPI_COL8(bj); const int h = c8 / 192, d = c8 - h * 192;
#pragma unroll
      for (int ai = 0; ai < 2; ++ai)
#pragma unroll
        for (int m = 0; m < 4; ++m) {
          const int rl = ai * 128 + wr * 64 + m * 16 + fr; const int row = u.pm * 256 + rl; const int b = row >> 12, s = row & 4095;
          const float rs = rstd[rl] * 0.10411756f;
          f32x4 v0 = acc[ai][bj][m][0], v1 = acc[ai][bj][m][1]; v0 *= rs; v1 *= rs;
          u16* qp = mq + (((size_t)b * 4 + h) * SEQ + s) * 192;
          if (d < 128) { *(uint4*)(qp + d) = pack8(v0, v1); }
          else {
            const int f = (d - 128) >> 1;
            const float4 cs = *(const float4*)(costab + (size_t)row * 32 + f), sn = *(const float4*)(sintab + (size_t)row * 32 + f);
            f32x4 o1, o2;
            o1[0] = v0[0] * cs.x - v1[0] * sn.x; o2[0] = v0[0] * sn.x + v1[0] * cs.x;
            o1[1] = v0[1] * cs.y - v1[1] * sn.y; o2[1] = v0[1] * sn.y + v1[1] * cs.y;
            o1[2] = v0[2] * cs.z - v1[2] * sn.z; o2[2] = v0[2] * sn.z + v1[2] * cs.z;
            o1[3] = v0[3] * cs.w - v1[3] * sn.w; o2[3] = v0[3] * sn.w + v1[3] * cs.w;
            *(uint2*)(qp + 128 + f) = pack4(o1);
            *(uint2*)(qp + 160 + f) = pack4(o2);
          }
        }
    }
  }
};
struct EpiLora {
  float* sW; u16 *sKKA, *sKP, *sG; const float *invn, *zk; const float *w0, *a0, *k_a, *k_k;
  DI void operator()(const Acc8& acc, const pg8::Unit& u, int wr, int wc, int fr, int fq) const {
    if (u.pn == 0) {
#pragma unroll
      for (int bj = 0; bj < 2; ++bj) {
        const int c8 = bj * 128 + wc * 32 + 8 * fq;
        const float4 w0a = *(const float4*)(w0 + c8), w0b = *(const float4*)(w0 + c8 + 4);
#pragma unroll
        for (int ai = 0; ai < 2; ++ai)
#pragma unroll
          for (int m = 0; m < 4; ++m) {
            const size_t o = (size_t)EPI_ROWS(ai, m) * 256 + c8;
            const f32x4 x0 = acc[ai][bj][m][0], x1 = acc[ai][bj][m][1];
            float4 d0, d1;
            d0.x = __expf(-__expf(-softplusf_(-(w0a.x + x0[0])) - 0.5f)); d0.y = __expf(-__expf(-softplusf_(-(w0a.y + x0[1])) - 0.5f));
            d0.z = __expf(-__expf(-softplusf_(-(w0a.z + x0[2])) - 0.5f)); d0.w = __expf(-__expf(-softplusf_(-(w0a.w + x0[3])) - 0.5f));
            d1.x = __expf(-__expf(-softplusf_(-(w0b.x + x1[0])) - 0.5f)); d1.y = __expf(-__expf(-softplusf_(-(w0b.y + x1[1])) - 0.5f));
            d1.z = __expf(-__expf(-softplusf_(-(w0b.z + x1[2])) - 0.5f)); d1.w = __expf(-__expf(-softplusf_(-(w0b.w + x1[3])) - 0.5f));
            *(float4*)(sW + o) = d0; *(float4*)(sW + o + 4) = d1;
            asm volatile("" ::: "memory"); __builtin_amdgcn_sched_barrier(0);
          }
      }
    } else if (u.pn == 1) {
#pragma unroll
      for (int bj = 0; bj < 2; ++bj) {
        const int c8 = bj * 128 + wc * 32 + 8 * fq;
        const float4 a0a = *(const float4*)(a0 + c8), a0b = *(const float4*)(a0 + c8 + 4);
        const float4 kaa = *(const float4*)(k_a + c8), kab = *(const float4*)(k_a + c8 + 4);
        const float4 kwa = *(const float4*)(k_k + c8), kwb = *(const float4*)(k_k + c8 + 4);
#pragma unroll
        for (int ai = 0; ai < 2; ++ai) {
          f32x4 kq0[4], kq1[4]; float invq[4];
#pragma unroll
          for (int m = 0; m < 4; ++m) {
            const unsigned row = (unsigned)EPI_ROWS(ai, m);
            kq0[m] = *(const f32x4*)((const char*)zk + (row * 256u + c8) * 4u); kq1[m] = *(const f32x4*)((const char*)zk + (row * 256u + c8) * 4u + 16);
            invq[m] = invn[row * 4u + (c8 >> 6)];
          }
#pragma unroll
          for (int m = 0; m < 4; ++m) {
            const unsigned o2 = ((unsigned)EPI_ROWS(ai, m) * 256u + c8) * 2u;
            const f32x4 k0 = kq0[m], k1 = kq1[m]; const float inv = invq[m];
            const f32x4 x0 = acc[ai][bj][m][0], x1 = acc[ai][bj][m][1];
            f32x4 kk0, kk1;
            kk0[0] = k0[0] * kwa.x * inv; kk0[1] = k0[1] * kwa.y * inv; kk0[2] = k0[2] * kwa.z * inv; kk0[3] = k0[3] * kwa.w * inv;
            kk1[0] = k1[0] * kwb.x * inv; kk1[1] = k1[1] * kwb.y * inv; kk1[2] = k1[2] * kwb.z * inv; kk1[3] = k1[3] * kwb.w * inv;
            f32x4 av0, av1, kka0, kka1, kp0, kp1;
            av0[0] = sigmoidf_(a0a.x + x0[0]); av0[1] = sigmoidf_(a0a.y + x0[1]); av0[2] = sigmoidf_(a0a.z + x0[2]); av0[3] = sigmoidf_(a0a.w + x0[3]);
            av1[0] = sigmoidf_(a0b.x + x1[0]); av1[1] = sigmoidf_(a0b.y + x1[1]); av1[2] = sigmoidf_(a0b.z + x1[2]); av1[3] = sigmoidf_(a0b.w + x1[3]);
            kka0 = kk0 * av0; kka1 = kk1 * av1;
            kp0[0] = k0[0] * (1.f + (av0[0] - 1.f) * kaa.x); kp0[1] = k0[1] * (1.f + (av0[1] - 1.f) * kaa.y);
            kp0[2] = k0[2] * (1.f + (av0[2] - 1.f) * kaa.z); kp0[3] = k0[3] * (1.f + (av0[3] - 1.f) * kaa.w);
            kp1[0] = k1[0] * (1.f + (av1[0] - 1.f) * kab.x); kp1[1] = k1[1] * (1.f + (av1[1] - 1.f) * kab.y);
            kp1[2] = k1[2] * (1.f + (av1[2] - 1.f) * kab.z); kp1[3] = k1[3] * (1.f + (av1[3] - 1.f) * kab.w);
            *(uint4*)((char*)sKKA + o2) = pack8(kka0, kka1); *(uint4*)((char*)sKP + o2) = pack8(kp0, kp1);
          }
          asm volatile("" ::: "memory"); __builtin_amdgcn_sched_barrier(0);
        }
      }
    } else {
#pragma unroll
      for (int bj = 0; bj < 2; ++bj) {
        const int c8 = bj * 128 + wc * 32 + 8 * fq;
#pragma unroll
        for (int ai = 0; ai < 2; ++ai)
#pragma unroll
          for (int m = 0; m < 4; ++m) {
            const size_t o = (size_t)EPI_ROWS(ai, m) * 256 + c8;
            *(uint4*)(sG + o) = pack8(acc[ai][bj][m][0], acc[ai][bj][m][1]);
          }
      }
    }
  }
};
template <int MODE>
struct EpiMerge {
  float* tmp; u16* merged; const u16* gates;
  DI void operator()(const Acc8& acc, const pg8::Unit& u, int wr, int wc, int fr, int fq) const {
    const unsigned r0 = (unsigned)(u.pm * 256 + wr * 64 + fr), c0 = (unsigned)(u.pn * 256 + wc * 32 + 8 * fq);
#pragma unroll
    for (int bj = 0; bj < 2; ++bj)
#pragma unroll
      for (int ai = 0; ai < 2; ++ai) {
        uint4 gu[4]; f32x4 t0[4], t1[4];
#pragma unroll
        for (int m = 0; m < 4; ++m) {
          const unsigned row = r0 + ai * 128 + m * 16, col = c0 + bj * 128;
          gu[m] = *(const uint4*)((const char*)gates + (row * 3072u + col) * 2u);
          if (MODE >= 1) { const char* tp = (const char*)tmp + (row * 1024u + col) * 4u; t0[m] = *(const f32x4*)(tp); t1[m] = *(const f32x4*)(tp + 16); }
        }
#pragma unroll
        for (int m = 0; m < 4; ++m) {
          const unsigned row = r0 + ai * 128 + m * 16, col = c0 + bj * 128;
          f32x4 v0 = acc[ai][bj][m][0] * unpack4(make_uint2(gu[m].x, gu[m].y));
          f32x4 v1 = acc[ai][bj][m][1] * unpack4(make_uint2(gu[m].z, gu[m].w));
          if (MODE >= 1) { v0 += t0[m]; v1 += t1[m]; }
          if (MODE <= 1) { char* tp = (char*)tmp + (row * 1024u + col) * 4u; *(f32x4*)(tp) = v0; *(f32x4*)(tp + 16) = v1; }
          else *(uint4*)((char*)merged + (row * 1024u + col) * 2u) = pack8(v0, v1);
        }
        asm volatile("" ::: "memory"); __builtin_amdgcn_sched_barrier(0);
      }
  }
};
template <int ACT>
struct EpiStore {
  u16* O; int ldc;
  DI void operator()(const Acc8& acc, const pg8::Unit& u, int wr, int wc, int fr, int fq) const {
#pragma unroll
    for (int ai = 0; ai < 2; ++ai)
#pragma unroll
      for (int m = 0; m < 4; ++m) {
        u16* rowp = O + (size_t)EPI_ROWS(ai, m) * ldc;
#pragma unroll
        for (int bj = 0; bj < 2; ++bj) {
          f32x4 v0 = acc[ai][bj][m][0], v1 = acc[ai][bj][m][1];
          if (ACT == 1) {
#pragma unroll
            for (int e = 0; e < 4; ++e) { const float r0 = fmaxf(v0[e], 0.f), r1 = fmaxf(v1[e], 0.f); v0[e] = r0 * r0; v1[e] = r1 * r1; }
          }
          *(uint4*)(rowp + EPI_COL8(bj)) = pack8(v0, v1);
        }
      }
  }
};

template <int MAP> DI int col_map(int n) {
  if (MAP == 1) {
    if (n < 1792) return n;
    if (n < 2496) return 1796 + (n - 1792);
    if (n < 2500) return 1792 + (n - 2496);
    if (n < 2560) return -1;
    return 2500 + (n - 2560);
  }
  if (MAP == 2) {
    const int h = n / 192, d = n - h * 192;
    if (d < 128) return n;
    const int j = d - 128, g = j >> 3, r = j & 7;
    return h * 192 + 128 + ((r < 4) ? (4 * g + r) : (32 + 4 * g + (r - 4)));
  }
  return n;
}
template <int MAP>
DI void conv_weight(float* ldsf, const float* __restrict__ src, u16* __restrict__ dst, const float* __restrict__ gain, int K, int N, int Npad, int bid, int nblk, int wid_k) {
  const int tid = otid(); const int tk = K >> 6; const int cnt = tk * (Npad >> 6);
  for (int it = bid; it < cnt; it += nblk) {
    const int kt = it % tk, nt = it / tk; const int k0 = kt * 64, n0 = nt * 64;
    __syncthreads();
    {
      const int nn = tid & 63; int n = col_map<MAP>(n0 + nn); if (n >= N) n = -1;
#pragma unroll 4
      for (int r = 0; r < 8; ++r) {
        const int kk = r * 8 + (tid >> 6);
        float v = 0.f;
        if (n >= 0) { v = src[(size_t)(k0 + kk) * N + n]; if (gain) v *= gain[k0 + kk]; }
        ldsf[kk * 65 + nn] = v;
      }
    }
    __syncthreads();
    {
      const int nn = tid >> 3, kb = (tid & 7) * 8;
      uint4 o;
      o.x = pack2(ldsf[(kb + 0) * 65 + nn], ldsf[(kb + 1) * 65 + nn]); o.y = pack2(ldsf[(kb + 2) * 65 + nn], ldsf[(kb + 3) * 65 + nn]);
      o.z = pack2(ldsf[(kb + 4) * 65 + nn], ldsf[(kb + 5) * 65 + nn]); o.w = pack2(ldsf[(kb + 6) * 65 + nn], ldsf[(kb + 7) * 65 + nn]);
      *(uint4*)(dst + (size_t)(n0 + nn) * K + k0 + kb) = o;
    }
  }
}

DI void rowwise_phase(const float* __restrict__ xin, float* __restrict__ xout, const u16* __restrict__ tbuf,
                      const float* __restrict__ gate, const float* __restrict__ pgain,
                      const float* __restrict__ pre_gain, const float* __restrict__ sc, const float* __restrict__ sh, u16* __restrict__ hbuf, int bid, int nblk, int wid_k) {
  const int tid = otid(); const int lane = tid & 63;
  const int gw = bid * 8 + (tid >> 6), nw = nblk * 8;
  for (int row = gw; row < T; row += nw) {
    const int b = row >> 12;
    float4 xv[4];
#pragma unroll
    for (int i = 0; i < 4; ++i) xv[i] = *(const float4*)(xin + (size_t)row * 1024 + i * 256 + lane * 4);
    if (tbuf) {
      float4 tv[4]; float ss = 0.f;
#pragma unroll
      for (int i = 0; i < 4; ++i) {
        const uint2 u = *(const uint2*)(tbuf + (size_t)row * 1024 + i * 256 + lane * 4);
        tv[i] = make_float4(bflo(u.x), bfhi(u.x), bflo(u.y), bfhi(u.y));
        ss += tv[i].x * tv[i].x + tv[i].y * tv[i].y + tv[i].z * tv[i].z + tv[i].w * tv[i].w;
      }
      ss = wave_sum(ss);
      const float rstd = rsqrtf(ss * (1.f / 1024.f) + 1e-6f);
#pragma unroll
      for (int i = 0; i < 4; ++i) {
        const int c = i * 256 + lane * 4;
        const float4 g = *(const float4*)(gate + (size_t)b * 6144 + c);
        const float4 pg = *(const float4*)(pgain + c);
        xv[i].x += g.x * (tv[i].x * rstd) * pg.x; xv[i].y += g.y * (tv[i].y * rstd) * pg.y;
        xv[i].z += g.z * (tv[i].z * rstd) * pg.z; xv[i].w += g.w * (tv[i].w * rstd) * pg.w;
      }
    }
#pragma unroll
    for (int i = 0; i < 4; ++i) *(float4*)(xout + (size_t)row * 1024 + i * 256 + lane * 4) = xv[i];
    if (hbuf) {
      float ss = 0.f;
#pragma unroll
      for (int i = 0; i < 4; ++i) ss += xv[i].x * xv[i].x + xv[i].y * xv[i].y + xv[i].z * xv[i].z + xv[i].w * xv[i].w;
      ss = wave_sum(ss);
      const float rstd = rsqrtf(ss * (1.f / 1024.f) + 1e-6f);
#pragma unroll
      for (int i = 0; i < 4; ++i) {
        const int c = i * 256 + lane * 4;
        const float4 g = *(const float4*)(pre_gain + c);
        const float4 s1 = *(const float4*)(sc + (size_t)b * 6144 + c);
        const float4 s0 = *(const float4*)(sh + (size_t)b * 6144 + c);
        f32x4 h;
        h[0] = xv[i].x * rstd * g.x * (1.f + s1.x) + s0.x; h[1] = xv[i].y * rstd * g.y * (1.f + s1.y) + s0.y;
        h[2] = xv[i].z * rstd * g.z * (1.f + s1.z) + s0.z; h[3] = xv[i].w * rstd * g.w * (1.f + s1.w) + s0.w;
        *(uint2*)(hbuf + (size_t)row * 1024 + c) = pack4(h);
      }
    }
  }
}

DI f32x4 sm4(const u16* __restrict__ z, const float* __restrict__ mu, int t, int c) {
  const uint2 cu = *(const uint2*)(z + (size_t)t * 1024 + c);
  uint2 pr = make_uint2(0u, 0u);
  if (t & (SEQ - 1)) pr = *(const uint2*)(z + (size_t)(t - 1) * 1024 + c);
  const float4 m = *(const float4*)(mu + c);
  const float x0 = bflo(cu.x), x1 = bfhi(cu.x), x2 = bflo(cu.y), x3 = bfhi(cu.y);
  f32x4 r;
  r[0] = x0 + (bflo(pr.x) - x0) * m.x; r[1] = x1 + (bfhi(pr.x) - x1) * m.y;
  r[2] = x2 + (bflo(pr.y) - x2) * m.z; r[3] = x3 + (bfhi(pr.y) - x3) * m.w;
  return r;
}
DI float sumsq8(uint4 u) {
  float s = 0.f, x;
  x = bflo(u.x); s += x * x; x = bfhi(u.x); s += x * x; x = bflo(u.y); s += x * x; x = bfhi(u.y); s += x * x;
  x = bflo(u.z); s += x * x; x = bfhi(u.z); s += x * x; x = bflo(u.w); s += x * x; x = bfhi(u.w); s += x * x;
  return s;
}
template <int NCOLS>
DI void block_rstd(float* tab, const u16* __restrict__ A, int m0, int wid_k) {
  const int tid = otid(), row = tid >> 1, half = tid & 1;
  const uint4* src = (const uint4*)(A + (size_t)(m0 + row) * NCOLS + half * (NCOLS / 2));
  float ss = 0.f;
#pragma unroll 4
  for (int i = 0; i < NCOLS / 16; ++i) ss += sumsq8(src[i]);
  ss += __shfl_xor(ss, 1);
  if (!half) tab[row] = rsqrtf(ss * (1.f / NCOLS) + 1e-6f);
}

#define MFMA32(a, b, c) __builtin_amdgcn_mfma_f32_32x32x16_bf16((a), (b), (c), 0, 0, 0)
template <int DK, int DV, bool BIAS>
DI void attn_item(u16* lds, const u16* __restrict__ Q, const u16* __restrict__ Kg, const u16* __restrict__ VT,
                  const float* __restrict__ cum, u16* __restrict__ O, int ldo, int bh, int qb, int wid_k) {
  constexpr int KSTR = DK + 8, NKS = DK / 16, NMB = DV / 32;
  constexpr int TILE_U16_ = 64 * KSTR + DV * 72 + 128;
  const int tid = otid(), lane = tid & 63, w = tid >> 6, l31 = lane & 31, h2 = lane >> 5;
  const int qrow = qb * 256 + w * 32 + l31;
  bf16x8 qf[NKS];
  {
    const u16* qp = Q + ((size_t)bh * SEQ + qrow) * DK + h2 * 8;
#pragma unroll
    for (int ks = 0; ks < NKS; ++ks) qf[ks] = *(const bf16x8*)(qp + ks * 16);
  }
  float cq = 0.f;
  if (BIAS) cq = cum[bh * SEQ + qrow];
  f32x16 o[NMB];
#pragma unroll
  for (int mb = 0; mb < NMB; ++mb)
#pragma unroll
    for (int i = 0; i < 16; ++i) o[mb][i] = 0.f;
  float mrun = -1e30f, lrun = 0.f;
  const int wq0 = qb * 256 + w * 32;
  const int ntiles = 4 * qb + 4;
  constexpr int NKL = (64 * DK / 8) / NTHR, NVL = (DV * 8) / NTHR;
  uint4 pk0, pk1, pk2, pv0, pv1; float pc_ = 0.f;
  pk0 = pk1 = pk2 = pv0 = pv1 = make_uint4(0u, 0u, 0u, 0u);
#define AK_(i) if (i < NKL) { const int c = tid + NTHR * i; const int row = c / (DK / 8), kc = c % (DK / 8); pk##i = *(const uint4*)(kp_ + (size_t)row * DK + kc * 8); }
#define AV_(i) if (i < NVL) { const int c = tid + NTHR * i; const int row = c >> 3, kc = c & 7; pv##i = *(const uint4*)(vp_ + (size_t)row * SEQ + kc * 8); }
#define ATT_ISSUE(k0_) do { const u16* kp_ = Kg + ((size_t)bh * SEQ + (k0_)) * DK; const u16* vp_ = VT + (size_t)bh * DV * SEQ + (k0_); \
    AK_(0) AK_(1) AK_(2) AV_(0) AV_(1) \
    if (BIAS) { if (tid < 64) pc_ = cum[bh * SEQ + (k0_) + tid]; } } while (0)
#define SK_(i) if (i < NKL) { const int c = tid + NTHR * i; const int row = c / (DK / 8), kc = c % (DK / 8); *(uint4*)(wK + row * KSTR + kc * 8) = pk##i; }
#define SV_(i) if (i < NVL) { const int c = tid + NTHR * i; const int row = c >> 3, kc = c & 7; *(uint4*)(wV + row * 72 + kc * 8) = pv##i; }
#define ATT_COMMIT(b_) do { u16* wK = lds + (b_) * TILE_U16_; u16* wV = wK + 64 * KSTR; float* wC = (float*)(wV + DV * 72); \
    SK_(0) SK_(1) SK_(2) SV_(0) SV_(1) if (BIAS) { if (tid < 64) wC[tid] = pc_; } } while (0)
  __syncthreads();
  ATT_ISSUE(0);
  ATT_COMMIT(0);
  if (ntiles > 1) ATT_ISSUE(64);
  for (int kt = 0; kt < ntiles; ++kt) {
    const int k0 = kt * 64;
    __syncthreads();
    if (kt + 1 < ntiles) { ATT_COMMIT((kt + 1) & 1); if (kt + 2 < ntiles) ATT_ISSUE(k0 + 128); }
    const u16* ldsK = lds + (kt & 1) * TILE_U16_; const u16* ldsV = ldsK + 64 * KSTR; const float* ldsC = (const float*)(ldsV + DV * 72);
#pragma unroll
    for (int kh = 0; kh < 2; ++kh) {
      const int kb = k0 + kh * 32;
      if (kb > wq0 + 31) continue;
      f32x16 st;
#pragma unroll
      for (int i = 0; i < 16; ++i) st[i] = 0.f;
      __builtin_amdgcn_s_setprio(1);
#pragma unroll
      for (int ks = 0; ks < NKS; ++ks) {
        const bf16x8 kf = *(const bf16x8*)(ldsK + (kh * 32 + l31) * KSTR + ks * 16 + h2 * 8);
        st = MFMA32(kf, qf[ks], st);
      }
      __builtin_amdgcn_s_setprio(0);
      if (BIAS) {
#pragma unroll
        for (int g = 0; g < 4; ++g) {
          const float4 ck = *(const float4*)(ldsC + kh * 32 + 8 * g + 4 * h2);
          st[4 * g + 0] += cq - ck.x; st[4 * g + 1] += cq - ck.y; st[4 * g + 2] += cq - ck.z; st[4 * g + 3] += cq - ck.w;
        }
      }
      if (kb + 31 > wq0) {
#pragma unroll
        for (int i = 0; i < 16; ++i) {
          const int key = kb + (i & 3) + 8 * (i >> 2) + 4 * h2;
          if (key > qrow) st[i] = -1e30f;
        }
      }
      float mx = st[0];
#pragma unroll
      for (int i = 1; i < 16; ++i) mx = fmaxf(mx, st[i]);
      { auto r_ = __builtin_amdgcn_permlane32_swap(__float_as_uint(mx), __float_as_uint(mx), false, false); mx = fmaxf(__uint_as_float(r_[0]), __uint_as_float(r_[1])); }
      const float mnew = fmaxf(mrun, mx);
      const float alpha = __builtin_amdgcn_exp2f(mrun - mnew);
      const bool resc = __builtin_amdgcn_ballot_w64(mnew > mrun) != 0ull;
      mrun = mnew;
      float ps = 0.f;
#pragma unroll
      for (int i = 0; i < 16; ++i) { st[i] = __builtin_amdgcn_exp2f(st[i] - mnew); ps += st[i]; }
      lrun = lrun * alpha + ps;
      if (resc) {
#pragma unroll
        for (int mb = 0; mb < NMB; ++mb)
#pragma unroll
          for (int i = 0; i < 16; ++i) o[mb][i] *= alpha;
      }
      bf16x8 pf[2];
#pragma unroll
      for (int s = 0; s < 2; ++s) {
        uint4 pk;
        pk.x = pack2(st[8 * s + 0], st[8 * s + 1]); pk.y = pack2(st[8 * s + 2], st[8 * s + 3]);
        pk.z = pack2(st[8 * s + 4], st[8 * s + 5]); pk.w = pack2(st[8 * s + 6], st[8 * s + 7]);
        pf[s] = __builtin_bit_cast(bf16x8, pk);
      }
      __builtin_amdgcn_s_setprio(1);
#pragma unroll
      for (int mb = 0; mb < NMB; ++mb)
#pragma unroll
        for (int s = 0; s < 2; ++s) {
          const u16* vpp = ldsV + (mb * 32 + l31) * 72 + kh * 32 + 16 * s + 4 * h2;
          const s16x4 lo = *(const s16x4*)(vpp);
          const s16x4 hi = *(const s16x4*)(vpp + 8);
          const bf16x8 vf = __builtin_shufflevector(lo, hi, 0, 1, 2, 3, 4, 5, 6, 7);
          o[mb] = MFMA32(vf, pf[s], o[mb]);
        }
      __builtin_amdgcn_s_setprio(0);
    }
  }
#undef AK_
#undef AV_
#undef ATT_ISSUE
#undef SK_
#undef SV_
#undef ATT_COMMIT
  { auto r_ = __builtin_amdgcn_permlane32_swap(__float_as_uint(lrun), __float_as_uint(lrun), false, false); lrun = __uint_as_float(r_[0]) + __uint_as_float(r_[1]); }
  const float inv = 1.f / lrun;
  const int b = bh >> 2, h = bh & 3;
  u16* op = O + ((size_t)b * SEQ + qrow) * ldo + h * DV;
#pragma unroll
  for (int mb = 0; mb < NMB; ++mb)
#pragma unroll
    for (int g = 0; g < 4; ++g) {
      f32x4 v;
      v[0] = o[mb][4 * g + 0] * inv; v[1] = o[mb][4 * g + 1] * inv; v[2] = o[mb][4 * g + 2] * inv; v[3] = o[mb][4 * g + 3] * inv;
      *(uint2*)(op + mb * 32 + 8 * g + 4 * h2) = pack4(v);
    }
}

DI void scan_block(float* ldsf, const u16* __restrict__ R, const u16* __restrict__ KP, const u16* __restrict__ KK, const u16* __restrict__ KKA,
                   const u16* __restrict__ V, const float* __restrict__ Wd, float* __restrict__ Y, int blk, int wid_k) {
  const int tid = otid(), lane = tid & 63, w = tid >> 6;
  const int bh = blk >> 2, rq = blk & 3, b = bh >> 2, h = bh & 3;
  const int ks = lane & 15, rowl = (w & 3) * 4 + (lane >> 4);
  const bool worker = (w < 4);
  float* ybuf = ldsf + 2 * 16 * 336;
  float S0 = 0.f, S1 = 0.f, S2 = 0.f, S3 = 0.f, yreg = 0.f;
  const size_t tb = (size_t)b * SEQ;
  const int hc = h * 64;
  const int a0i = tid >> 7, a0step = (tid & 127) >> 3, a0c = (tid & 7) * 8;
  const int wstep = (tid & 255) >> 4, wc = (tid & 15) * 4;
  const int vstep = (tid & 31) >> 1, vhalf = tid & 1;
  uint4 p0, pv; float4 pw;
  p0 = pv = make_uint4(0u, 0u, 0u, 0u); pw = make_float4(0.f, 0.f, 0.f, 0.f);
#define SCAN_ISSUE(c_) do { \
    const size_t t0_ = tb + (size_t)(c_) * 16; \
    const u16* s0_ = (a0i == 0 ? KK : (a0i == 1 ? KKA : (a0i == 2 ? KP : R))); \
    p0 = *(const uint4*)(s0_ + (t0_ + a0step) * 256 + hc + a0c); \
    if (tid < 256) pw = *(const float4*)(Wd + (t0_ + wstep) * 256 + hc + wc); \
    if (tid >= 256 && tid < 288) pv = *(const uint4*)(V + (t0_ + vstep) * 256 + hc + rq * 16 + vhalf * 8); \
  } while (0)
#define SCAN_COMMIT(bufi_) do { \
    float* bp_ = ldsf + (bufi_) * 16 * 336; \
    float* d0_ = bp_ + a0step * 336 + 64 + a0i * 64 + a0c; \
    *(float4*)(d0_) = make_float4(bflo(p0.x), bfhi(p0.x), bflo(p0.y), bfhi(p0.y)); \
    *(float4*)(d0_ + 4) = make_float4(bflo(p0.z), bfhi(p0.z), bflo(p0.w), bfhi(p0.w)); \
    if (tid < 256) *(float4*)(bp_ + wstep * 336 + wc) = pw; \
    if (tid >= 256 && tid < 288) { \
      float* dv_ = bp_ + vstep * 336 + 320 + vhalf * 8; \
      *(float4*)(dv_) = make_float4(bflo(pv.x), bfhi(pv.x), bflo(pv.y), bfhi(pv.y)); \
      *(float4*)(dv_ + 4) = make_float4(bflo(pv.z), bfhi(pv.z), bflo(pv.w), bfhi(pv.w)); \
    } \
  } while (0)
  __syncthreads();
  SCAN_ISSUE(0);
  SCAN_COMMIT(0);
  __syncthreads();
  for (int c = 0; c < SEQ / 16; ++c) {
    const int cur = c & 1;
    if (c + 1 < SEQ / 16) SCAN_ISSUE(c + 1);
    const float* bp = ldsf + cur * 16 * 336;
    float* yb = ybuf + cur * 256;
    if (worker) {
      typedef float f2 __attribute__((ext_vector_type(2)));
      f2 Sa = {S0, S1}, Sb = {S2, S3};
      float4 w4 = *(const float4*)(bp + ks * 4);
      float4 kk4 = *(const float4*)(bp + 64 + ks * 4);
      float4 ka4 = *(const float4*)(bp + 128 + ks * 4);
      float4 kp4 = *(const float4*)(bp + 192 + ks * 4);
      float4 r4 = *(const float4*)(bp + 256 + ks * 4);
      float vv = bp[320 + rowl];
      float yp = 0.f;
#pragma unroll
      for (int step = 0; step < 16; ++step) {
        float4 w4n = w4, kk4n = kk4, ka4n = ka4, kp4n = kp4, r4n = r4; float vvn = vv;
        if (step + 1 < 16) {
          const float* sp = bp + (step + 1) * 336;
          w4n = *(const float4*)(sp + ks * 4);
          kk4n = *(const float4*)(sp + 64 + ks * 4);
          ka4n = *(const float4*)(sp + 128 + ks * 4);
          kp4n = *(const float4*)(sp + 192 + ks * 4);
          r4n = *(const float4*)(sp + 256 + ks * 4);
          vvn = sp[320 + rowl];
        }
        const f2 kka = {kk4.x, kk4.y}, kkb = {kk4.z, kk4.w}, wa = {w4.x, w4.y}, wb = {w4.z, w4.w};
        const f2 kaa = {ka4.x, ka4.y}, kab = {ka4.z, ka4.w}, kpa = {kp4.x, kp4.y}, kpb = {kp4.z, kp4.w};
        const f2 ra = {r4.x, r4.y}, rb = {r4.z, r4.w};
        const f2 d2 = Sa * kka + Sb * kkb;
        float d = d2.x + d2.y;
        const f2 ta = Sa * wa + kpa * vv, tb = Sb * wb + kpb * vv;
        d = dpp_add<0xB1>(d); yp = dpp_add<0xB1>(yp);
        d = dpp_add<0x4E>(d); yp = dpp_add<0x4E>(yp);
        d = dpp_add<0x141>(d); yp = dpp_add<0x141>(yp);
        d = dpp_add<0x140>(d); yp = dpp_add<0x140>(yp);
        if (step > 0) yreg = (ks == step - 1) ? yp : yreg;
        Sa = ta - kaa * d; Sb = tb - kab * d;
        const f2 y2 = Sa * ra + Sb * rb;
        yp = y2.x + y2.y;
        w4 = w4n; kk4 = kk4n; ka4 = ka4n; kp4 = kp4n; r4 = r4n; vv = vvn;
      }
      yp = reduce16(yp);
      yreg = (ks == 15) ? yp : yreg;
      S0 = Sa.x; S1 = Sa.y; S2 = Sb.x; S3 = Sb.y;
      yb[ks * 16 + rowl] = yreg;
    }
    if (c + 1 < SEQ / 16) SCAN_COMMIT(cur ^ 1);
    __syncthreads();
    if (tid < 256) {
      const int step = tid >> 4, row = tid & 15;
      Y[(tb + (size_t)c * 16 + step) * 256 + hc + rq * 16 + row] = yb[tid];
    }
  }
  __syncthreads();
#undef SCAN_ISSUE
#undef SCAN_COMMIT
}

#define XB_TMO      128
#define XB_XCNT(j)  (256  + 64 * (j))
#define XB_XSUB(j)  (1280 + 64 * (j))
#define XB_XGEN(j)  (2304 + 64 * (j))
#define XB_TOP      3328
#define XB_TOPGEN   3392
#define XCD_BAR_WORDS 3456
#define XB_SPIN_CAP (1u << 22)
DI unsigned xb_ld(unsigned* p)              { return __hip_atomic_load(p, __ATOMIC_RELAXED, __HIP_MEMORY_SCOPE_AGENT); }
DI unsigned xb_add(unsigned* p, unsigned v) { return __hip_atomic_fetch_add(p, v, __ATOMIC_RELAXED, __HIP_MEMORY_SCOPE_AGENT); }
DI unsigned xb_xcc_id() { return (unsigned)__builtin_amdgcn_s_getreg((3 << 11) | 20) & 0xFu; }
#define XB_SPIN(cond, bar) do { unsigned _sp = 0; while (cond) { __builtin_amdgcn_s_sleep(1); \
    if ((++_sp & 255u) == 0u) { if (xb_ld(&(bar)[XB_TMO])) break; if (_sp > XB_SPIN_CAP) { atomicAdd(&(bar)[XB_TMO], 1u); break; } } } } while (0)
struct XcdBarrier { unsigned* bar; unsigned x; volatile LAS unsigned* st; };
DI XcdBarrier xcd_barrier_post(unsigned* bar, volatile LAS unsigned* st, int wid_k) {
    XcdBarrier b; b.bar = bar; b.x = xb_xcc_id(); b.st = st;
    if (otid() == 0) (void)xb_add(&bar[XB_XCNT(b.x)], 1u);
    return b;
}
DI void xcd_barrier_complete(unsigned* bar, unsigned x, unsigned& nloc, unsigned& nx) {
    const unsigned G = gridDim.x * gridDim.y * gridDim.z;
    unsigned sum, cnt, mine, sp = 0u;
    for (;;) {
        sum = 0u; cnt = 0u; mine = 0u;
#pragma unroll
        for (unsigned j = 0; j < 16; ++j) { const unsigned c = xb_ld(&bar[XB_XCNT(j)]); sum += c; cnt += (c > 0u) ? 1u : 0u; mine = (j == x) ? c : mine; }
        if (sum == G) break;
        __builtin_amdgcn_s_sleep(1);
        if ((++sp & 255u) == 0u) { if (xb_ld(&bar[XB_TMO])) break; if (sp > XB_SPIN_CAP) { atomicAdd(&bar[XB_TMO], 1u); break; } }
    }
    nloc = mine > 0u ? mine : 1u; nx = cnt > 0u ? cnt : 1u;
}
DI void xcd_barrier(const XcdBarrier& b, int wid_k) {
    asm volatile("s_waitcnt vmcnt(0)" ::: "memory");
    __syncthreads();
    if (otid() == 0) {
        unsigned* bar = b.bar;
        __builtin_amdgcn_s_waitcnt(0);
        unsigned nloc = b.st[0], nx = b.st[1];
        if (nloc == 0u) { xcd_barrier_complete(bar, b.x, nloc, nx); b.st[0] = nloc; b.st[1] = nx; }
        const unsigned old = xb_add(&bar[XB_XSUB(b.x)], 1u);
        const unsigned gen = old / nloc;
        if (old + 1u == (gen + 1u) * nloc) {
            __builtin_amdgcn_fence(__ATOMIC_RELEASE, "agent");
            asm volatile("s_waitcnt vmcnt(0)" ::: "memory");
            const unsigned og = xb_add(&bar[XB_TOP], 1u);
            const unsigned tg = og / nx;
            if (og + 1u == (tg + 1u) * nx) xb_add(&bar[XB_TOPGEN], 1u);
            else XB_SPIN(xb_ld(&bar[XB_TOPGEN]) == tg, bar);
            __builtin_amdgcn_fence(__ATOMIC_ACQUIRE, "agent");
            xb_add(&bar[XB_XGEN(b.x)], 1u);
            asm volatile("s_waitcnt vmcnt(0)" ::: "memory");
        } else {
            XB_SPIN(xb_ld(&bar[XB_XGEN(b.x)]) == gen, bar);
            __builtin_amdgcn_fence(__ATOMIC_ACQUIRE, "agent");
            asm volatile("s_waitcnt vmcnt(0)" ::: "memory");
        }
    }
    __syncthreads();
}

#define GAS __attribute__((address_space(1)))

DI bool bid_is_scan(unsigned b) { return b < 64u; }
DI void sub_barrier(unsigned* w, unsigned need, int wid_k) {
    asm volatile("s_waitcnt vmcnt(0)" ::: "memory");
    __syncthreads();
    if (otid() == 0) {
        __builtin_amdgcn_fence(__ATOMIC_RELEASE, "agent");
        asm volatile("s_waitcnt vmcnt(0)" ::: "memory");
        (void)xb_add(w, 1u);
        unsigned sp = 0u;
        while (xb_ld(w) < need) { __builtin_amdgcn_s_sleep(2); if (++sp > (1u << 24)) break; }
        __builtin_amdgcn_fence(__ATOMIC_ACQUIRE, "agent");
        asm volatile("s_waitcnt vmcnt(0)" ::: "memory");
    }
    __syncthreads();
}
DI void sub_wait(unsigned* w, unsigned need, int wid_k) {
    __syncthreads();
    if (otid() == 0) {
        unsigned sp = 0u;
        while (xb_ld(w) < need) { __builtin_amdgcn_s_sleep(8); if (++sp > (1u << 24)) break; }
        __builtin_amdgcn_fence(__ATOMIC_ACQUIRE, "agent");
        asm volatile("s_waitcnt vmcnt(0)" ::: "memory");
    }
    __syncthreads();
}
#define GAS __attribute__((address_space(1)))
#define PHASE_BEGIN() size_t oz_ = 0; asm volatile("" : "+s"(oz_)); int oi_ = 0; asm volatile("" : "+s"(oi_)); GAS unsigned char* wsg_ = (GAS unsigned char*)p.ws; asm volatile("" : "+s"(wsg_)); unsigned char* const ws = (unsigned char*)wsg_; (void)ws; \
  const int tid = otid(); const int lane = tid & 63, wv = tid >> 6; \
  int bid = blockIdx.x; asm volatile("" : "+s"(bid)); int nblk = gridDim.x; asm volatile("" : "+s"(nblk)); \
  const int gtid = bid * NTHR + tid, gthreads = nblk * NTHR; (void)lane; (void)wv; (void)gtid; (void)gthreads
#define INP(TY, i) ((const TY*)((const char*)(p.in[(i) + oi_]) + oz_))
#define OUTP() ((float*)((char*)(p.out) + oz_))
#define WSP(TY, off) ((TY*)(ws + (off)))
#define GSYNC() do { XcdBarrier xb_; xb_.bar = (unsigned*)(p.ws + OFF_CTL); xb_.x = xb_xcc_id(); xb_.st = (volatile LAS unsigned*)(lds_raw + LDS_MISC + 4096); xcd_barrier(xb_, wid_k); } while (0)
#define CONVERT_LAYER(lc_, wselc_) do { \
    conv_weight<1>(ldsf, INP(float, 3) + (size_t)lc_ * 1024 * 5572, WSP(u16, OFF_WIN + wselc_), nullptr, 1024, 5572, INP, bid, nblk, wid_k); \
    conv_weight<2>(ldsf, INP(float, 17) + (size_t)lc_ * 384 * 768, WSP(u16, OFF_WQ + wselc_), INP(float, 16) + lc_ * 384, 384, 768, 768, bid, nblk, wid_k); \
    conv_weight<0>(ldsf, INP(float, 19) + (size_t)lc_ * 256 * 1024, WSP(u16, OFF_WKV + wselc_), INP(float, 18) + lc_ * 256, 256, 1024, 1024, bid, nblk, wid_k); \
    conv_weight<0>(ldsf, INP(float, 20) + (size_t)lc_ * 256 * 1024, WSP(u16, OFF_WA + wselc_), nullptr, 256, 1024, 1024, bid, nblk, wid_k); \
    conv_weight<0>(ldsf, INP(float, 21) + (size_t)lc_ * 256 * 1024, WSP(u16, OFF_WB + wselc_), nullptr, 256, 1024, 1024, bid, nblk, wid_k); \
    conv_weight<0>(ldsf, INP(float, 22) + (size_t)lc_ * 512 * 1024, WSP(u16, OFF_WC + wselc_), nullptr, 512, 1024, 1024, bid, nblk, wid_k); \
    conv_weight<0>(ldsf, INP(float, 23) + (size_t)lc_ * 1024 * 1024, WSP(u16, OFF_WOUT + wselc_), nullptr, 1024, 1024, 1024, bid, nblk, wid_k); \
    conv_weight<0>(ldsf, INP(float, 30) + (size_t)lc_ * 1024 * 4096, WSP(u16, OFF_WUP + wselc_), nullptr, 1024, 4096, 4096, bid, nblk, wid_k); \
    conv_weight<0>(ldsf, INP(float, 31) + (size_t)lc_ * 4096 * 1024, WSP(u16, OFF_WDN + wselc_), nullptr, 4096, 1024, 1024, bid, nblk, wid_k); \
    { \
      const float* wd = INP(float, 6) + (size_t)lc_ * 64 * 256; const float* wa = INP(float, 8) + (size_t)lc_ * 64 * 256; const float* wg = INP(float, 9) + (size_t)lc_ * 128 * 256; \
      u16* wl = WSP(u16, OFF_WLORA + wselc_); \
      for (int i = gtid; i < 768 * 256; i += gthreads) { \
        const int n = i >> 8, k = i & 255; float v = 0.f; \
        if (n < 256) { if (k < 64) v = wd[k * 256 + n]; } \
        else if (n < 512) { if (k >= 64 && k < 128) v = wa[(k - 64) * 256 + (n - 256)]; } \
        else { if (k >= 128) v = wg[(k - 128) * 256 + (n - 512)]; } \
        wl[i] = f2bf(v); \
      } \
    } \
  } while (0)
__global__ void __launch_bounds__(NTHR, 2) fwd_kernel(Params p) {
  extern __shared__ __attribute__((aligned(16))) unsigned char lds_raw[];
  cg::grid_group grid = cg::this_grid();
  u16* lds = (u16*)lds_raw;
  float* ldsf = (float*)lds_raw;
  LAS unsigned char* ldsg = (LAS unsigned char*)lds_raw;
  float* ldsmisc = (float*)(lds_raw + LDS_MISC);
  volatile LAS unsigned* bst = (volatile LAS unsigned*)(lds_raw + LDS_MISC + 4096);
  const int wid_k = __builtin_amdgcn_readfirstlane((int)threadIdx.x >> 6);
  { const int t0_ = otid(); if (t0_ < 4) bst[t0_] = 0u; }
  __syncthreads();
  (void)xcd_barrier_post((unsigned*)(p.ws + OFF_CTL), bst, wid_k);

  {
  PHASE_BEGIN();
  const int* in_pos = INP(int, 2); const float* in_c = INP(float, 1); const float* w_mod = INP(float, 24);
  float* costab = WSP(float, OFF_COS); float* sintab = WSP(float, OFF_SIN); float* modp = WSP(float, OFF_MODP);
  for (int i = gtid; i < T * 32; i += gthreads) {
    const int t = i >> 5, f = i & 31;
    const float pos = (float)in_pos[t];
    const float invf = powf(10000.f, -(float)(2 * f) / 64.f);
    const float ang = pos * invf;
    costab[i] = cosf(ang); sintab[i] = sinf(ang);
  }
  {
    for (int i = tid; i < 4096; i += NTHR) { const float v = in_c[i]; ldsf[i] = v / (1.f + expf(-v)); }
    __syncthreads();
    for (int it = bid; it < 4 * 12 * 8; it += nblk) {
      const int l = it / 96, rem = it - l * 96, nch = rem >> 3, ks = rem & 7;
      const int n = nch * 512 + tid;
      float a0_ = 0.f, a1_ = 0.f, a2_ = 0.f, a3_ = 0.f;
      const float* wp = w_mod + ((size_t)l * 1024 + ks * 128) * 6144 + n;
#pragma unroll 8
      for (int k = 0; k < 128; ++k) {
        const float wv_ = wp[(size_t)k * 6144];
        const int kk = ks * 128 + k;
        a0_ += ldsf[kk] * wv_; a1_ += ldsf[1024 + kk] * wv_; a2_ += ldsf[2048 + kk] * wv_; a3_ += ldsf[3072 + kk] * wv_;
      }
      float* mp = modp + ((size_t)(ks * 4 + l) * 4) * 6144 + n;
      mp[0] = a0_; mp[6144] = a1_; mp[2 * 6144] = a2_; mp[3 * 6144] = a3_;
    }
  }
  }
  grid.sync();
  {
  PHASE_BEGIN();
  const float* b_mod = INP(float, 25); const float* modp = WSP(float, OFF_MODP); float* mod = WSP(float, OFF_MOD);
  for (int i = gtid; i < 4 * 4 * 6144; i += gthreads) {
    const int l = i / (4 * 6144), n = i % 6144;
    float v = b_mod[l * 6144 + n];
#pragma unroll
    for (int ks = 0; ks < 8; ++ks) v += modp[(size_t)ks * 98304 + i];
    mod[i] = v;
  }
  }
  GSYNC();

  for (int l = 0; l < 4; ++l) {
    const size_t wsel = (l & 1) ? (size_t)(WS_END - OFF_WIN) : (size_t)0;
    {
    PHASE_BEGIN();
    if (l == 0) CONVERT_LAYER(0, (size_t)0);
    const float* mod = WSP(float, OFF_MOD); const float* modl = mod + (size_t)l * 4 * 6144;
    if (l == 0)
      rowwise_phase(INP(float, 0), OUTP(), nullptr, nullptr, nullptr, INP(float, 26), modl + 1024, modl + 0, WSP(u16, OFF_HBUF), bid, nblk, wid_k);
    else
      rowwise_phase(OUTP(), OUTP(), WSP(u16, OFF_TBUF), mod + (size_t)(l - 1) * 4 * 6144 + 5120, INP(float, 29) + (l - 1) * 1024,
                    INP(float, 26) + l * 1024, modl + 1024, modl + 0, WSP(u16, OFF_HBUF), bid, nblk, wid_k);
    }
    GSYNC();

    {
    PHASE_BEGIN();
    pg8::Gemm g{WSP(u16, OFF_HBUF), WSP(u16, OFF_WIN + wsel), 1024, 1024, 1024};
    pg8::StaticOrder S; S.init(T, 1024, nblk, bid);
    EpiStore<0> E{WSP(u16, OFF_ZRAW), 1024};
    pg8::gemm_phase(ldsg, g, S, E, wid_k);
    }
    GSYNC();

    {
    PHASE_BEGIN();
    const u16* zraw = WSP(u16, OFF_ZRAW); const float* mu = INP(float, 4) + l * 1024; const float* k_k = INP(float, 10) + l * 256;
    u16* sR = WSP(u16, OFF_SR); u16* sV = WSP(u16, OFF_SV); u16* sKK = WSP(u16, OFF_SKK); float* zk = WSP(float, OFF_ZK); float* invn = WSP(float, OFF_INVN); u16* zl = WSP(u16, OFF_ZL);
    const int c = lane * 4;
    const float4 kkw = *(const float4*)(k_k + c);
    for (int t = bid * 8 + wv; t < T; t += nblk * 8) {
      const size_t o = (size_t)t * 256 + c;
      const f32x4 r = sm4(zraw, mu, t, c), k = sm4(zraw, mu, t, 256 + c), v = sm4(zraw, mu, t, 512 + c);
      f32x4 lo = sm4(zraw, mu, t, 768 + c);
      f32x4 kk; kk[0] = k[0] * kkw.x; kk[1] = k[1] * kkw.y; kk[2] = k[2] * kkw.z; kk[3] = k[3] * kkw.w;
      const float ss = reduce16(kk[0] * kk[0] + kk[1] * kk[1] + kk[2] * kk[2] + kk[3] * kk[3]);
      const float inv = 1.f / fmaxf(sqrtf(ss), 1e-12f);
      kk *= inv;
      if ((lane & 15) == 0) invn[(size_t)t * 4 + (lane >> 4)] = inv;
      if (c < 64) {
#pragma unroll
        for (int e = 0; e < 4; ++e) lo[e] = tanhf(lo[e]);
      } else if (c >= 128) {
#pragma unroll
        for (int e = 0; e < 4; ++e) lo[e] = sigmoidf_(lo[e]);
      }
      *(uint2*)(sR + o) = pack4(r); *(f32x4*)(zk + o) = k; *(uint2*)(sV + o) = pack4(v);
      *(uint2*)(sKK + o) = pack4(kk); *(uint2*)(zl + o) = pack4(lo);
    }
    }
    GSYNC();

    {
    PHASE_BEGIN();
    if (bid >= 64) {
      pg8::StaticOrder S0; S0.init(T, 768, 192, bid - 64);
      pg8::Unit u0; const bool ok0 = S0.next(0, u0);
      int pm_ = u0.pm, pn_ = u0.pn; asm volatile("" : "+s"(pm_), "+s"(pn_));
      pg8::OneUnit S{pm_, pn_, ok0 ? 1 : 0};
      pg8::Gemm g{WSP(u16, OFF_ZL), WSP(u16, OFF_WLORA + wsel), 256, 768, 256};
      EpiLora E{WSP(float, OFF_SW), WSP(u16, OFF_SKKA), WSP(u16, OFF_SKP), WSP(u16, OFF_SG), WSP(float, OFF_INVN), WSP(float, OFF_ZK),
                INP(float, 5) + l * 256, INP(float, 7) + l * 256, INP(float, 11) + l * 256, INP(float, 10) + l * 256};
      pg8::gemm_phase(ldsg, g, S, E, wid_k);
      __syncthreads();
    }
    }
    GSYNC();

    if (bid_is_scan(blockIdx.x)) {
      {
      PHASE_BEGIN();
      __builtin_amdgcn_s_setprio(3);
      scan_block(ldsf, WSP(u16, OFF_SR), WSP(u16, OFF_SKP), WSP(u16, OFF_SKK), WSP(u16, OFF_SKKA), WSP(u16, OFF_SV), WSP(float, OFF_SW), WSP(float, OFF_Y), bid, wid_k);
      __builtin_amdgcn_s_setprio(0);
      sub_wait(WSP(unsigned, OFF_CTL) + 4096 + (l * 2 + 1) * 64, 192u, wid_k);
      }
    } else {
      {
      PHASE_BEGIN();
      pg8::Gemm g{WSP(u16, OFF_HBUF), WSP(u16, OFF_WIN + wsel) + (size_t)1024 * 1024, 1024, 4608, 1024};
      pg8::StaticOrder S; S.init(T, 4608, 192, bid - 64);
      EpiInProj E{WSP(u16, OFF_ZRAW), WSP(u16, OFF_FQ), WSP(u16, OFF_FK), WSP(u16, OFF_FVT), WSP(u16, OFF_ZQ), WSP(u16, OFF_ZKV), WSP(u16, OFF_ZPE),
                  WSP(u16, OFF_GATES), WSP(float, OFF_FLOG), INP(float, 15) + l * 4, 1024};
      pg8::gemm_phase(ldsg, g, S, E, wid_k);
      sub_barrier(WSP(unsigned, OFF_CTL) + 4096 + (l * 2 + 0) * 64, 192u, wid_k);
      }
#pragma unroll 1
      for (int rnd = 0; rnd < 3; ++rnd) {
      PHASE_BEGIN();
      const int c = bid - 64;
      const bool do_kv = (rnd == 0) || (rnd == 1 && c < 64);
      const bool do_q = (rnd == 1 && c >= 64) || (rnd == 2 && c < 64);
      if (do_kv) {
        pg8::StaticOrder S0; S0.init(T, 1024, 256, rnd == 0 ? c : 192 + c);
        pg8::Unit u0; const bool ok0 = S0.next(0, u0);
        if (ok0) block_rstd<256>(ldsmisc, WSP(u16, OFF_ZKV), u0.pm * 256, wid_k);
        __syncthreads();
        int pm_ = u0.pm, pn_ = u0.pn; asm volatile("" : "+s"(pm_), "+s"(pn_));
        pg8::OneUnit S{pm_, pn_, ok0 ? 1 : 0};
        pg8::Gemm g{WSP(u16, OFF_ZKV), WSP(u16, OFF_WKV + wsel), 256, 1024, 256};
        EpiKv E{WSP(u16, OFF_MK), WSP(u16, OFF_MVT), ldsmisc};
        pg8::gemm_phase(ldsg, g, S, E, wid_k);
        __syncthreads();
      } else if (do_q) {
        pg8::StaticOrder S0; S0.init(T, 768, 192, rnd == 1 ? c - 64 : 128 + c);
        pg8::Unit u0; const bool ok0 = S0.next(0, u0);
        if (ok0) block_rstd<384>(ldsmisc, WSP(u16, OFF_ZQ), u0.pm * 256, wid_k);
        __syncthreads();
        int pm_ = u0.pm, pn_ = u0.pn; asm volatile("" : "+s"(pm_), "+s"(pn_));
        pg8::OneUnit S{pm_, pn_, ok0 ? 1 : 0};
        pg8::Gemm g{WSP(u16, OFF_ZQ), WSP(u16, OFF_WQ + wsel), 384, 768, 384};
        EpiQ E{WSP(u16, OFF_MQ), ldsmisc, WSP(float, OFF_COS), WSP(float, OFF_SIN)};
        pg8::gemm_phase(ldsg, g, S, E, wid_k);
        __syncthreads();
      }
      }
      {
      PHASE_BEGIN();
      const int c = bid - 64;
      if (c >= 176) {
        const int tid = otid();
        const int bh = c - 176, b = bh >> 2, h = bh & 3;
        const float* flog = WSP(float, OFF_FLOG); float* cum = WSP(float, OFF_CUM);
        float run = 0.f;
#pragma unroll
        for (int e = 0; e < 8; ++e) run += flog[((size_t)b * SEQ + tid * 8 + e) * 4 + h];
        __syncthreads();
        ldsf[tid] = run;
        __syncthreads();
        float base = 0.f;
        for (int j = 0; j < tid; ++j) base += ldsf[j];
#pragma unroll
        for (int e = 0; e < 8; ++e) { base += flog[((size_t)b * SEQ + tid * 8 + e) * 4 + h]; cum[bh * SEQ + tid * 8 + e] = base * 1.44269504f; }
        __syncthreads();
      } else if (c >= 64) {
        const int tid = otid();
        const u16* zpe = WSP(u16, OFF_ZPE); const float* costab = WSP(float, OFF_COS); const float* sintab = WSP(float, OFF_SIN); u16* mk = WSP(u16, OFF_MK);
        for (int idx = (c - 64) * NTHR + tid; idx < T * 32; idx += 112 * NTHR) {
          const int m = idx >> 5, f = idx & 31; const int b = m >> 12, s = m & 4095;
          const float x1 = bflo((unsigned)zpe[(size_t)m * 64 + f]), x2 = bflo((unsigned)zpe[(size_t)m * 64 + 32 + f]);
          const float cs = costab[idx], sn = sintab[idx];
          const u16 o1 = f2bf(x1 * cs - x2 * sn), o2 = f2bf(x1 * sn + x2 * cs);
#pragma unroll
          for (int hh = 0; hh < 4; ++hh) { u16* kp = mk + (((size_t)b * 4 + hh) * SEQ + s) * 192 + 128; kp[f] = o1; kp[32 + f] = o2; }
        }
      }
      sub_barrier(WSP(unsigned, OFF_CTL) + 4096 + (l * 2 + 1) * 64, 192u, wid_k);
      }
    }
    {
    PHASE_BEGIN();
    unsigned* ctl = WSP(unsigned, OFF_CTL);
    for (;;) {
      __syncthreads();
      if (tid == 0) ((volatile unsigned*)ldsmisc)[256] = atomicAdd(&ctl[64 + l], 1u);
      __syncthreads();
      const unsigned it = ((volatile unsigned*)ldsmisc)[256];
      if (it >= 512u) break;
      if (it < 256u) { const int qb = 15 - (int)(it >> 4), bh = it & 15; attn_item<192, 128, false>(lds, WSP(u16, OFF_MQ), WSP(u16, OFF_MK), WSP(u16, OFF_MVT), nullptr, WSP(u16, OFF_YC), 512, bh, qb, wid_k); }
      else { const unsigned i2 = it - 256u; const int qb = 15 - (int)(i2 >> 4), bh = i2 & 15; attn_item<64, 64, true>(lds, WSP(u16, OFF_FQ), WSP(u16, OFF_FK), WSP(u16, OFF_FVT), WSP(float, OFF_CUM), WSP(u16, OFF_YB), 256, bh, qb, wid_k); }
    }
    if (l < 3) { const int ln = l + 1; const size_t wseln = (ln & 1) ? (size_t)(WS_END - OFF_WIN) : (size_t)0; __syncthreads(); CONVERT_LAYER(ln, wseln); }
    }
    GSYNC();

    {
      PHASE_BEGIN();
      const float* ln_x_g = INP(float, 13); const float* ln_x_b = INP(float, 14); const float* r_k = INP(float, 12);
      const float* Ybuf = WSP(float, OFF_Y); const u16* sR = WSP(u16, OFF_SR); const u16* sKP = WSP(u16, OFF_SKP);
      const u16* sV = WSP(u16, OFF_SV); const u16* sG = WSP(u16, OFF_SG); u16* ya = WSP(u16, OFF_YA);
      const int gw = bid * 8 + wv, nw = nblk * 8;
      const int c = lane * 4;
      const float4 lg = *(const float4*)(ln_x_g + l * 256 + c), lb = *(const float4*)(ln_x_b + l * 256 + c);
      const float4 rkw = *(const float4*)(r_k + l * 256 + c);
      for (int t = gw; t < T; t += nw) {
        const float4 y = *(const float4*)(Ybuf + (size_t)t * 256 + c);
        const float mean = reduce16(y.x + y.y + y.z + y.w) * (1.f / 64.f);
        const float d0 = y.x - mean, d1 = y.y - mean, d2 = y.z - mean, d3 = y.w - mean;
        const float var = reduce16(d0 * d0 + d1 * d1 + d2 * d2 + d3 * d3) * (1.f / 64.f);
        const float rstd = rsqrtf(var + 64e-5f);
        const uint2 r = *(const uint2*)(sR + (size_t)t * 256 + c), k = *(const uint2*)(sKP + (size_t)t * 256 + c);
        const uint2 v = *(const uint2*)(sV + (size_t)t * 256 + c), g = *(const uint2*)(sG + (size_t)t * 256 + c);
        const float rk = reduce16(bflo(r.x) * bflo(k.x) * rkw.x + bfhi(r.x) * bfhi(k.x) * rkw.y + bflo(r.y) * bflo(k.y) * rkw.z + bfhi(r.y) * bfhi(k.y) * rkw.w);
        f32x4 o;
        o[0] = (d0 * rstd * lg.x + lb.x + rk * bflo(v.x)) * bflo(g.x);
        o[1] = (d1 * rstd * lg.y + lb.y + rk * bfhi(v.x)) * bfhi(g.x);
        o[2] = (d2 * rstd * lg.z + lb.z + rk * bflo(v.y)) * bflo(g.y);
        o[3] = (d3 * rstd * lg.w + lb.w + rk * bfhi(v.y)) * bfhi(g.y);
        *(uint2*)(ya + (size_t)t * 256 + c) = pack4(o);
      }
    }
    GSYNC();

    {
    PHASE_BEGIN();
    pg8::StaticOrder S0; S0.init(T, 1024, nblk, bid);
    pg8::Unit u0; const bool ok0 = S0.next(0, u0);
    int pm_ = u0.pm, pn_ = u0.pn; asm volatile("" : "+s"(pm_), "+s"(pn_));
    pg8::OneUnit S{pm_, pn_, ok0 ? 1 : 0};
    const u16* gates = WSP(u16, OFF_GATES); float* tmp = WSP(float, OFF_TMP); u16* merged = WSP(u16, OFF_MERGED);
    { pg8::Gemm g{WSP(u16, OFF_YC), WSP(u16, OFF_WC + wsel), 512, 1024, 512}; EpiMerge<0> E{tmp, merged, gates + 2048}; pg8::gemm_phase(ldsg, g, S, E, wid_k); }
    asm volatile("s_waitcnt vmcnt(0)" ::: "memory");
    { pg8::Gemm g{WSP(u16, OFF_YA), WSP(u16, OFF_WA + wsel), 256, 1024, 256}; EpiMerge<1> E{tmp, merged, gates}; pg8::gemm_phase(ldsg, g, S, E, wid_k); }
    asm volatile("s_waitcnt vmcnt(0)" ::: "memory");
    { pg8::Gemm g{WSP(u16, OFF_YB), WSP(u16, OFF_WB + wsel), 256, 1024, 256}; EpiMerge<2> E{tmp, merged, gates + 1024}; pg8::gemm_phase(ldsg, g, S, E, wid_k); }
    }
    GSYNC();

    {
    PHASE_BEGIN();
    pg8::Gemm g{WSP(u16, OFF_MERGED), WSP(u16, OFF_WOUT + wsel), 1024, 1024, 1024};
    pg8::StaticOrder S; S.init(T, 1024, nblk, bid);
    EpiStore<0> E{WSP(u16, OFF_TBUF), 1024};
    pg8::gemm_phase(ldsg, g, S, E, wid_k);
    }
    GSYNC();

    {
    PHASE_BEGIN();
    const float* modl = WSP(float, OFF_MOD) + (size_t)l * 4 * 6144;
    rowwise_phase(OUTP(), OUTP(), WSP(u16, OFF_TBUF), modl + 2048, INP(float, 27) + l * 1024, INP(float, 28) + l * 1024, modl + 4096, modl + 3072, WSP(u16, OFF_HBUF), bid, nblk, wid_k);
    }
    GSYNC();

    {
    PHASE_BEGIN();
    pg8::Gemm g{WSP(u16, OFF_HBUF), WSP(u16, OFF_WUP + wsel), 1024, 4096, 1024};
    pg8::StaticOrder S; S.init(T, 4096, nblk, bid);
    EpiStore<1> E{WSP(u16, OFF_UBUF), 4096};
    pg8::gemm_phase(ldsg, g, S, E, wid_k);
    }
    GSYNC();

    {
    PHASE_BEGIN();
    pg8::Gemm g{WSP(u16, OFF_UBUF), WSP(u16, OFF_WDN + wsel), 4096, 1024, 4096};
    pg8::StaticOrder S; S.init(T, 1024, nblk, bid);
    EpiStore<0> E{WSP(u16, OFF_TBUF), 1024};
    pg8::gemm_phase(ldsg, g, S, E, wid_k);
    }
    GSYNC();
  }
  {
  PHASE_BEGIN();
  rowwise_phase(OUTP(), OUTP(), WSP(u16, OFF_TBUF), WSP(float, OFF_MOD) + (size_t)3 * 4 * 6144 + 5120, INP(float, 29) + 3 * 1024, nullptr, nullptr, nullptr, nullptr, bid, nblk, wid_k);
  }
}

extern "C" void kernel_launch(void* const* d_in, const int* in_sizes, int n_in, void* d_out, int out_size, void* d_ws, size_t ws_size,
                              hipStream_t stream) {
  static int grid_blocks = 0;
  if (!grid_blocks) {
    int dev = 0, cus = 0, per_cu = 0;
    (void)hipGetDevice(&dev);
    (void)hipDeviceGetAttribute(&cus, hipDeviceAttributeMultiprocessorCount, dev);
    (void)hipFuncSetAttribute((const void*)fwd_kernel, hipFuncAttributeMaxDynamicSharedMemorySize, LDS_BYTES);
    (void)hipOccupancyMaxActiveBlocksPerMultiprocessor(&per_cu, (const void*)fwd_kernel, NTHR, LDS_BYTES);
    if (per_cu < 1) fprintf(stderr, "kernel_launch: occupancy query says %d workgroups per CU\n", per_cu);
    grid_blocks = 256;
    if (cus != 256) fprintf(stderr, "kernel_launch: device has %d CUs, kernel is laid out for 256\n", cus);
    if (ws_size < WS_END + (OFF_ACT - OFF_WIN)) fprintf(stderr, "kernel_launch: workspace too small: %zu < %zu\n", ws_size, (size_t)WS_END);
  }
  (void)hipMemsetAsync((char*)d_ws + OFF_CTL, 0, 65536, stream);
  Params p{};
  for (int i = 0; i < 32; ++i) p.in[i] = d_in[i];
  p.out = (float*)d_out; p.ws = (unsigned char*)d_ws;
  void* args[] = {&p};
  hipError_t e = hipLaunchCooperativeKernel((const void*)fwd_kernel, dim3(grid_blocks), dim3(NTHR), args, LDS_BYTES, stream);
  if (e != hipSuccess) fprintf(stderr, "cooperative launch failed: %s (grid %d)\n", hipGetErrorString(e), grid_blocks);
}
```

```cpp
#include <hip/hip_runtime.h>
#include <hip/hip_cooperative_groups.h>
#include <stdint.h>
#include <stdio.h>
namespace cg = cooperative_groups;

#define DI __device__ __forceinline__
#define LAS __attribute__((address_space(3)))
typedef unsigned short u16;
typedef __attribute__((ext_vector_type(8))) short bf16x8;
typedef __attribute__((ext_vector_type(4))) short s16x4;
typedef __attribute__((ext_vector_type(4))) float f32x4;
typedef __attribute__((ext_vector_type(16))) float f32x16;
typedef __attribute__((ext_vector_type(2))) float f32v2;
typedef __attribute__((ext_vector_type(2))) __bf16 bf16v2;

constexpr int T = 16384;
constexpr int SEQ = 4096;
constexpr int INP = 5632;
constexpr int NTHR = 512;
constexpr int LDS_BYTES = 147456;
constexpr int LDS_MISC = 131072;

constexpr size_t OFF_CTL  = 0;
constexpr size_t OFF_MODP = 65536;
constexpr size_t OFF_MOD  = OFF_MODP + 8ull * 4 * 4 * 6144 * 4;
constexpr size_t OFF_COS  = OFF_MOD + 4ull * 4 * 6144 * 4;
constexpr size_t OFF_SIN  = OFF_COS + (size_t)T * 32 * 4;
constexpr size_t OFF_FLOG = OFF_SIN + (size_t)T * 32 * 4;
constexpr size_t OFF_CUM  = OFF_FLOG + (size_t)T * 4 * 4;
constexpr size_t OFF_INVN = OFF_CUM + 16ull * 4096 * 4;
constexpr size_t OFF_WIN  = OFF_INVN + (size_t)T * 4 * 4;
constexpr size_t OFF_WQ   = OFF_WIN + (size_t)INP * 1024 * 2;
constexpr size_t OFF_WKV  = OFF_WQ + 768ull * 384 * 2;
constexpr size_t OFF_WA   = OFF_WKV + 1024ull * 256 * 2;
constexpr size_t OFF_WB   = OFF_WA + 1024ull * 256 * 2;
constexpr size_t OFF_WC   = OFF_WB + 1024ull * 256 * 2;
constexpr size_t OFF_WOUT = OFF_WC + 1024ull * 512 * 2;
constexpr size_t OFF_WUP  = OFF_WOUT + 1024ull * 1024 * 2;
constexpr size_t OFF_WDN  = OFF_WUP + 4096ull * 1024 * 2;
constexpr size_t OFF_WLORA = OFF_WDN + 4096ull * 1024 * 2;
constexpr size_t OFF_ACT  = OFF_WLORA + 768ull * 256 * 2;
constexpr size_t OFF_GATES = OFF_ACT;
constexpr size_t OFF_ZRAW  = OFF_GATES + (size_t)T * 3072 * 2;
constexpr size_t OFF_UBUF  = OFF_GATES;
constexpr size_t OFF_Z2    = OFF_ZRAW + (size_t)T * 1024 * 2;
constexpr size_t OFF_ZQ    = OFF_Z2;
constexpr size_t OFF_ZKV   = OFF_ZQ + (size_t)T * 384 * 2;
constexpr size_t OFF_ZPE   = OFF_ZKV + (size_t)T * 256 * 2;
constexpr size_t OFF_ZK    = OFF_ZPE + (size_t)T * 64 * 2;
constexpr size_t OFF_ZL    = OFF_ZK + (size_t)T * 256 * 4;
constexpr size_t OFF_Z2END = OFF_ZL + (size_t)T * 256 * 2;
constexpr size_t OFF_Y     = OFF_ZRAW;
constexpr size_t OFF_YB    = OFF_Y + (size_t)T * 256 * 4;
constexpr size_t OFF_YA    = OFF_YB + (size_t)T * 256 * 2;
constexpr size_t OFF_YC    = OFF_Z2END;
constexpr size_t OFF_RS   = OFF_YC + (size_t)T * 512 * 2;
constexpr size_t OFF_SR   = OFF_RS;
constexpr size_t OFF_SKP  = OFF_SR + (size_t)T * 256 * 2;
constexpr size_t OFF_SKK  = OFF_SKP + (size_t)T * 256 * 2;
constexpr size_t OFF_SKKA = OFF_SKK + (size_t)T * 256 * 2;
constexpr size_t OFF_SV   = OFF_SKKA + (size_t)T * 256 * 2;
constexpr size_t OFF_SW   = OFF_SV + (size_t)T * 256 * 2;
constexpr size_t OFF_SG   = OFF_SW + (size_t)T * 256 * 4;
constexpr size_t OFF_TMP  = OFF_RS;
constexpr size_t OFF_TBUF = OFF_RS;
constexpr size_t OFF_RM   = OFF_SG + (size_t)T * 256 * 2;
constexpr size_t OFF_MQ   = OFF_RM;
constexpr size_t OFF_MK   = OFF_MQ + (size_t)T * 768 * 2;
constexpr size_t OFF_MVT  = OFF_MK + (size_t)T * 768 * 2;
constexpr size_t OFF_FQ   = OFF_MVT + (size_t)T * 512 * 2;
constexpr size_t OFF_FK   = OFF_FQ + (size_t)T * 256 * 2;
constexpr size_t OFF_FVT  = OFF_FK + (size_t)T * 256 * 2;
constexpr size_t OFF_MERGED = OFF_RM;
constexpr size_t OFF_HBUF = OFF_RM;
constexpr size_t WS_END   = OFF_FVT + (size_t)T * 256 * 2;

struct Params { const void* in[32]; float* out; unsigned char* ws; };

DI int otid_(int wid) { int l; asm volatile("v_mbcnt_lo_u32_b32 %0, -1, 0\n\tv_mbcnt_hi_u32_b32 %0, -1, %0" : "=v"(l)); return (wid << 6) | l; }
#define otid() otid_(wid_k)
DI float bflo(unsigned u) { return __uint_as_float(u << 16); }
DI float bfhi(unsigned u) { return __uint_as_float(u & 0xffff0000u); }
DI unsigned pack2(float a, float b) { f32v2 v = {a, b}; bf16v2 r = __builtin_convertvector(v, bf16v2); return __builtin_bit_cast(unsigned, r); }
DI u16 f2bf(float a) { return (u16)(pack2(a, 0.f) & 0xffffu); }
DI uint2 pack4(f32x4 v) { uint2 r; r.x = pack2(v[0], v[1]); r.y = pack2(v[2], v[3]); return r; }
DI uint4 pack8(f32x4 a, f32x4 b) { uint4 r; r.x = pack2(a[0], a[1]); r.y = pack2(a[2], a[3]); r.z = pack2(b[0], b[1]); r.w = pack2(b[2], b[3]); return r; }
DI f32x4 unpack4(uint2 u) { f32x4 r; r[0] = bflo(u.x); r[1] = bfhi(u.x); r[2] = bflo(u.y); r[3] = bfhi(u.y); return r; }
DI float sigmoidf_(float x) { return 1.f / (1.f + __expf(-x)); }
DI float softplusf_(float x) { return fmaxf(x, 0.f) + log1pf(__expf(-fabsf(x))); }
template <int CTRL> DI float dpp_add(float v) {
  int t = __builtin_amdgcn_update_dpp(0, __float_as_int(v), CTRL, 0xF, 0xF, true);
  return v + __int_as_float(t);
}
DI float reduce16(float v) {
  v = dpp_add<0xB1>(v);
  v = dpp_add<0x4E>(v);
  v = dpp_add<0x141>(v);
  v = dpp_add<0x140>(v);
  return v;
}

DI float wave_sum(float v) {
  v = reduce16(v);
  { auto r = __builtin_amdgcn_permlane16_swap(__float_as_uint(v), __float_as_uint(v), false, false); v = __uint_as_float(r[0]) + __uint_as_float(r[1]); }
  { auto r = __builtin_amdgcn_permlane32_swap(__float_as_uint(v), __float_as_uint(v), false, false); v = __uint_as_float(r[0]) + __uint_as_float(r[1]); }
  return v;
}
namespace pg8 {
constexpr int BM = 256, BK = 64, HALF = 128, HTB = HALF * BK * 2, NXCD = 8, WGM = 8;
DI int lds_byte(int r, int c) { const int st = (r >> 4) * 2 + (c >> 5), rr = r & 15, cc = c & 31, ob = rr * 64 + cc * 2; return st * 1024 + (ob ^ (((ob >> 9) & 1) << 5)); }
DI void stage_rc(int b, int& R, int& C) { const int st = b / 1024, sb = b % 1024, swz = sb ^ (((sb >> 9) & 1) << 5); R = (st >> 1) * 16 + swz / 64; C = (st & 1) * 32 + (swz % 64) / 2; }
DI int perm32(int rho) { const int n = rho >> 4, i = rho & 15; return 8 * (i >> 2) + 4 * n + (i & 3); }
struct Unit { int pm, pn; };
struct Gemm { const u16* A; const u16* Bt; int lda, N, K; };
struct StaticOrder {
  int nM, nN, nwg, G, c;
  DI void init(int M, int N, int G_, int c_) { nM = M / BM; nN = N / BM; nwg = nM * nN; G = G_; c = c_; }
  DI bool next(int i, Unit& u) const {
    const long L = (long)i * G + c; if (L >= nwg) return false;
    int wgid = (int)L; { const int q = nwg / NXCD, r = nwg % NXCD, xcd = wgid % NXCD, off = wgid / NXCD; wgid = (xcd < r ? xcd * (q + 1) : r * (q + 1) + (xcd - r) * q) + off; }
    const int nig = WGM * nN, gid = wgid / nig, fm = gid * WGM, gsz = (nM - fm) < WGM ? (nM - fm) : WGM;
    u.pm = fm + ((wgid % nig) % gsz); u.pn = (wgid % nig) / gsz; return true;
  }
};

struct OneUnit { int pm, pn, valid; DI bool next(int i, Unit& u) const { if (i != 0 || !valid) return false; u.pm = pm; u.pn = pn; return true; } };
template <class Epi, class Sched>
DI void gemm_phase(LAS unsigned char* lds, const Gemm g, const Sched& S, const Epi& E, int wid_k) {
  const int tid = otid(), wid = __builtin_amdgcn_readfirstlane(tid >> 6), lane = tid & 63, wr = wid >> 2, wc = wid & 3, fr = lane & 15, fq = lane >> 4;
  const int K = g.K, nt = K / BK;
  unsigned voffA[2], voffB[2];
#pragma unroll
  for (int i = 0; i < 2; ++i) { int R, C; stage_rc(tid * 16 + i * 8192, R, C); const int Rb = (R & ~31) + perm32(R & 31);
    voffA[i] = (unsigned)(R * g.lda + C) * 2u; voffB[i] = (unsigned)(Rb * K + C) * 2u; }
  const size_t kstep = (size_t)(BK * 2);
  const size_t hstepA = (size_t)HALF * g.lda * 2, hstepB = (size_t)HALF * K * 2;
  const size_t tstepA = 2 * hstepA, tstepB = 2 * hstepB;
  const unsigned ldsw = (unsigned)wid * 1024u;
  const int aoff = lds_byte(wr * 64 + fr, fq * 8), boff = lds_byte(wc * 32 + fr, fq * 8);
#define PG8_SA(b, h) (((b) * 2 + (h)) * HTB)
#define PG8_SB(b, h) ((4 + (b) * 2 + (h)) * HTB)
#define PG8_STAGE(bufoff, gbase, voff) do { _Pragma("unroll") for (int _i = 0; _i < 2; ++_i) \
    __builtin_amdgcn_global_load_lds((const unsigned*)((const char*)(gbase) + (voff)[_i]), (LAS unsigned*)(lds + (bufoff) + ldsw + _i * 8192), 16, 0, 0); } while (0)
#define PG8_LDA(dst, b, h) do { _Pragma("unroll") for (int m = 0; m < 4; ++m) _Pragma("unroll") for (int k = 0; k < 2; ++k) dst[m][k] = *(const LAS bf16x8*)(lds + PG8_SA(b, h) + aoff + m * 2048 + k * 1024); } while (0)
#define PG8_LDB(dst, b, h) do { _Pragma("unroll") for (int n = 0; n < 2; ++n) _Pragma("unroll") for (int k = 0; k < 2; ++k) dst[n][k] = *(const LAS bf16x8*)(lds + PG8_SB(b, h) + boff + n * 2048 + k * 1024); } while (0)
#define PG8_MMA(ai, bj, At, Bt) do { __builtin_amdgcn_s_setprio(1); _Pragma("unroll") for (int m = 0; m < 4; ++m) _Pragma("unroll") for (int n = 0; n < 2; ++n) _Pragma("unroll") for (int k = 0; k < 2; ++k) \
    acc[ai][bj][m][n] = __builtin_amdgcn_mfma_f32_16x16x32_bf16(Bt[n][k], At[m][k], acc[ai][bj][m][n], 0, 0, 0); __builtin_amdgcn_s_setprio(0); } while (0)
#define PG8_WAIT_V(n) asm volatile("s_waitcnt vmcnt(" #n ")" ::: "memory")
#define PG8_WAIT_L(n) asm volatile("s_waitcnt lgkmcnt(" #n ")" ::: "memory")
#define PG8_BAR __builtin_amdgcn_s_barrier()
#define PG8_SCHED __builtin_amdgcn_sched_barrier(0)
  Unit cur, nxt; int ui = 0;
  if (!S.next(0, cur)) return;
  f32x4 acc[2][2][4][2];
#pragma unroll
  for (int a = 0; a < 2; ++a)
#pragma unroll
    for (int b = 0; b < 2; ++b)
#pragma unroll
      for (int m = 0; m < 4; ++m)
#pragma unroll
        for (int n = 0; n < 2; ++n) acc[a][b][m][n] = (f32x4){0.f, 0.f, 0.f, 0.f};
  bf16x8 At[4][2], B0[2][2], B1[2][2];
  const char* cA = (const char*)g.A + (size_t)cur.pm * tstepA; const char* cB = (const char*)g.Bt + (size_t)cur.pn * tstepB;
  PG8_STAGE(PG8_SB(0, 0), cB, voffB); PG8_STAGE(PG8_SA(0, 0), cA, voffA); PG8_STAGE(PG8_SB(0, 1), cB + hstepB, voffB); PG8_STAGE(PG8_SA(0, 1), cA + hstepA, voffA);
  if (wr == 1) PG8_BAR;
  PG8_WAIT_V(4); PG8_BAR;
  PG8_STAGE(PG8_SB(1, 0), cB + kstep, voffB); PG8_STAGE(PG8_SA(1, 0), cA + kstep, voffA); PG8_STAGE(PG8_SB(1, 1), cB + hstepB + kstep, voffB);
  PG8_WAIT_V(6); PG8_BAR;
  for (;;) {
    const bool has_next = S.next(ui + 1, nxt);
    const char* nA = has_next ? (const char*)g.A + (size_t)nxt.pm * tstepA : cA; const char* nB = has_next ? (const char*)g.Bt + (size_t)nxt.pn * tstepB : cB;
    for (int t = 0; t < nt; t += 2) {
      const bool last = (t == nt - 2);
      const char* a1 = cA + (size_t)(t + 1) * kstep;
      const char* a2 = last ? nA : cA + (size_t)(t + 2) * kstep; const char* b2 = last ? nB : cB + (size_t)(t + 2) * kstep;
      const char* a3 = a2 + kstep; const char* b3 = b2 + kstep;
      PG8_LDB(B0, 0, 0); PG8_SCHED; PG8_LDA(At, 0, 0); PG8_STAGE(PG8_SA(1, 1), a1 + hstepA, voffA);
      PG8_WAIT_L(8); PG8_BAR; PG8_WAIT_L(0); PG8_MMA(0, 0, At, B0); PG8_BAR; PG8_SCHED;
      PG8_LDB(B1, 0, 1); PG8_STAGE(PG8_SB(0, 0), b2, voffB);
      PG8_BAR; PG8_WAIT_L(0); PG8_MMA(0, 1, At, B1); PG8_BAR;
      PG8_LDA(At, 0, 1); PG8_STAGE(PG8_SA(0, 0), a2, voffA);
      PG8_BAR; PG8_WAIT_L(0); PG8_MMA(1, 0, At, B0); PG8_BAR; PG8_SCHED;
      PG8_STAGE(PG8_SB(0, 1), b2 + hstepB, voffB);
      PG8_WAIT_V(6); PG8_BAR; PG8_MMA(1, 1, At, B1); PG8_BAR;
      PG8_LDB(B0, 1, 0); PG8_SCHED; PG8_LDA(At, 1, 0); PG8_STAGE(PG8_SA(0, 1), a2 + hstepA, voffA);
      PG8_WAIT_L(8); PG8_BAR; PG8_WAIT_L(0); PG8_MMA(0, 0, At, B0); PG8_BAR; PG8_SCHED;
      PG8_LDB(B1, 1, 1); PG8_STAGE(PG8_SB(1, 0), b3, voffB);
      PG8_BAR; PG8_WAIT_L(0); PG8_MMA(0, 1, At, B1); PG8_BAR;
      PG8_LDA(At, 1, 1); PG8_STAGE(PG8_SA(1, 0), a3, voffA);
      PG8_BAR; PG8_WAIT_L(0); PG8_MMA(1, 0, At, B0); PG8_BAR; PG8_SCHED;
      PG8_STAGE(PG8_SB(1, 1), b3 + hstepB, voffB);
      PG8_WAIT_V(6); PG8_BAR; PG8_MMA(1, 1, At, B1); PG8_BAR;
    }
    { int fr_ = fr, fq_ = fq, wr_ = wr, wc_ = wc; asm volatile("" : "+v"(fr_), "+v"(fq_)); asm volatile("" : "+s"(wr_), "+s"(wc_)); E(acc, cur, wr_, wc_, fr_, fq_); }
    if (!has_next) break;
#pragma unroll
    for (int a = 0; a < 2; ++a)
#pragma unroll
      for (int b = 0; b < 2; ++b)
#pragma unroll
        for (int m = 0; m < 4; ++m)
#pragma unroll
          for (int n = 0; n < 2; ++n) acc[a][b][m][n] = (f32x4){0.f, 0.f, 0.f, 0.f};
    cur = nxt; cA = nA; cB = nB; ++ui;
  }
  PG8_WAIT_V(0);
  if (wr == 0) PG8_BAR;
  PG8_BAR;
#undef PG8_SA
#undef PG8_SB
#undef PG8_STAGE
#undef PG8_LDA
#undef PG8_LDB
#undef PG8_MMA
#undef PG8_WAIT_V
#undef PG8_WAIT_L
#undef PG8_BAR
#undef PG8_SCHED
}
}
typedef f32x4 Acc8[2][2][4][2];
#define EPI_ROWS(ai, m) (u.pm * 256 + (ai) * 128 + wr * 64 + (m) * 16 + fr)
#define EPI_COL8(bj) (u.pn * 256 + (bj) * 128 + wc * 32 + 8 * fq)

struct EpiInProj {
  u16 *zraw, *fq_, *fk_, *fvT, *zq, *zkv, *zpe, *gates; float* flog; const float* b_forget; int coff;
  DI void operator()(const Acc8& acc, const pg8::Unit& u, int wr, int wc, int fr, int fq) const {
#pragma unroll
    for (int bj = 0; bj < 2; ++bj) {
      const int c32 = coff + u.pn * 256 + bj * 128 + wc * 32;
      const int c8 = c32 + 8 * fq;
#pragma unroll
      for (int ai = 0; ai < 2; ++ai)
#pragma unroll
        for (int m = 0; m < 4; ++m) {
          const int row = EPI_ROWS(ai, m); const int b = row >> 12, s = row & 4095;
          f32x4 v0 = acc[ai][bj][m][0], v1 = acc[ai][bj][m][1];
          if (c32 < 1024) { *(uint4*)(zraw + (size_t)row * 1024 + c8) = pack8(v0, v1); }
          else if (c32 < 1792) {
            const int c = c8 - 1024, part = c >> 8, hc = c & 255, h = hc >> 6, d = hc & 63; const size_t bh = (size_t)b * 4 + h;
            if (part == 0) { v0 *= 0.18033688f; v1 *= 0.18033688f; *(uint4*)(fq_ + (bh * SEQ + s) * 64 + d) = pack8(v0, v1); }
            else if (part == 1) { *(uint4*)(fk_ + (bh * SEQ + s) * 64 + d) = pack8(v0, v1); }
            else {
#pragma unroll
              for (int e = 0; e < 4; ++e) { fvT[(bh * 64 + d + e) * SEQ + s] = f2bf(v0[e]); fvT[(bh * 64 + d + 4 + e) * SEQ + s] = f2bf(v1[e]); }
            }
          }
          else if (c32 < 2176) { *(uint4*)(zq + (size_t)row * 384 + (c8 - 1792)) = pack8(v0, v1); }
          else if (c32 < 2432) { *(uint4*)(zkv + (size_t)row * 256 + (c8 - 2176)) = pack8(v0, v1); }
          else if (c32 < 2496) { *(uint4*)(zpe + (size_t)row * 64 + (c8 - 2432)) = pack8(v0, v1); }
          else if (c32 < 2560) {
            if (c8 == 2496) {
              float4 lf;
              { const float x = v0[0] + b_forget[0]; lf.x = fminf(x, 0.f) - log1pf(__expf(-fabsf(x))); }
              { const float x = v0[1] + b_forget[1]; lf.y = fminf(x, 0.f) - log1pf(__expf(-fabsf(x))); }
              { const float x = v0[2] + b_forget[2]; lf.z = fminf(x, 0.f) - log1pf(__expf(-fabsf(x))); }
              { const float x = v0[3] + b_forget[3]; lf.w = fminf(x, 0.f) - log1pf(__expf(-fabsf(x))); }
              *(float4*)(flog + (size_t)row * 4) = lf;
            }
          }
          else {
#pragma unroll
            for (int e = 0; e < 4; ++e) { v0[e] = sigmoidf_(v0[e]); v1[e] = sigmoidf_(v1[e]); }
            *(uint4*)(gates + (size_t)row * 3072 + (c8 - 2560)) = pack8(v0, v1);
          }
        }
    }
  }
};
struct EpiKv {
  u16 *mk, *mvT; const float* rstd;
  DI void operator()(const Acc8& acc, const pg8::Unit& u, int wr, int wc, int fr, int fq) const {
    const int d0 = wc * 32 + 8 * fq;
#pragma unroll
    for (int ai = 0; ai < 2; ++ai)
#pragma unroll
      for (int m = 0; m < 4; ++m) {
        const int rl = ai * 128 + wr * 64 + m * 16 + fr; const int row = u.pm * 256 + rl; const int b = row >> 12, s = row & 4095;
        const float rs = rstd[rl]; const unsigned bh = (unsigned)(b * 4 + u.pn);
        { f32x4 v0 = acc[ai][0][m][0], v1 = acc[ai][0][m][1]; v0 *= rs; v1 *= rs;
          *(uint4*)((char*)mk + ((bh * SEQ + s) * 192u + d0) * 2u) = pack8(v0, v1); }
        { f32x4 v0 = acc[ai][1][m][0], v1 = acc[ai][1][m][1]; v0 *= rs; v1 *= rs;
          const unsigned vo = ((bh * 128u + d0) * SEQ + s) * 2u;
#pragma unroll
          for (int e = 0; e < 4; ++e) { *(u16*)((char*)mvT + (vo + (unsigned)(e * (SEQ * 2)))) = f2bf(v0[e]); *(u16*)((char*)mvT + (vo + (unsigned)((4 + e) * (SEQ * 2)))) = f2bf(v1[e]); } }
        asm volatile("" ::: "memory"); __builtin_amdgcn_sched_barrier(0);
      }
  }
};
struct EpiQ {
  u16* mq; const float* rstd; const float *costab, *sintab;
  DI void operator()(const Acc8& acc, const pg8::Unit& u, int wr, int wc, int fr, int fq) const {
#pragma unroll
    for (int bj = 0; bj < 2; ++bj) {
      const int c8 = EPI_COL8(bj); const int h = c8 / 192, d = c8 - h * 192;
#pragma unroll
      for (int ai = 0; ai < 2; ++ai)
#pragma unroll
        for (int m = 0; m < 4; ++m) {
          const int rl = ai * 128 + wr * 64 + m * 16 + fr; const int row = u.pm * 256 + rl; const int b = row >> 12, s = row & 4095;
          const float rs = rstd[rl] * 0.10411756f;
          f32x4 v0 = acc[ai][bj][m][0], v1 = acc[ai][bj][m][1]; v0 *= rs; v1 *= rs;
          u16* qp = mq + (((size_t)b * 4 + h) * SEQ + s) * 192;
          if (d < 128) { *(uint4*)(qp + d) = pack8(v0, v1); }
          else {
            const int f = (d - 128) >> 1;
            const float4 cs = *(const float4*)(costab + (size_t)row * 32 + f), sn = *(const float4*)(sintab + (size_t)row * 32 + f);
            f32x4 o1, o2;
            o1[0] = v0[0] * cs.x - v1[0] * sn.x; o2[0] = v0[0] * sn.x + v1[0] * cs.x;
            o1[1] = v0[1] * cs.y - v1[1] * sn.y; o2[1] = v0[1] * sn.y + v1[1] * cs.y;
            o1[2] = v0[2] * cs.z - v1[2] * sn.z; o2[2] = v0[2] * sn.z + v1[2] * cs.z;
            o1[3] = v0[3] * cs.w - v1[3] * sn.w; o2[3] = v0[3] * sn.w + v1[3] * cs.w;
            *(uint2*)(qp + 128 + f) = pack4(o1);
            *(uint2*)(qp + 160 + f) = pack4(o2);
          }
        }
    }
  }
};
struct EpiLora {
  float* sW; u16 *sKKA, *sKP, *sG; const float *invn, *zk; const float *w0, *a0, *k_a, *k_k;
  DI void operator()(const Acc8& acc, const pg8::Unit& u, int wr, int wc, int fr, int fq) const {
    if (u.pn == 0) {
#pragma unroll
      for (int bj = 0; bj < 2; ++bj) {
        const int c8 = bj * 128 + wc * 32 + 8 * fq;
        const float4 w0a = *(const float4*)(w0 + c8), w0b = *(const float4*)(w0 + c8 + 4);
#pragma unroll
        for (int ai = 0; ai < 2; ++ai)
#pragma unroll
          for (int m = 0; m < 4; ++m) {
            const size_t o = (size_t)EPI_ROWS(ai, m) * 256 + c8;
            const f32x4 x0 = acc[ai][bj][m][0], x1 = acc[ai][bj][m][1];
            float4 d0, d1;
            d0.x = __expf(-__expf(-softplusf_(-(w0a.x + x0[0])) - 0.5f)); d0.y = __expf(-__expf(-softplusf_(-(w0a.y + x0[1])) - 0.5f));
            d0.z = __expf(-__expf(-softplusf_(-(w0a.z + x0[2])) - 0.5f)); d0.w = __expf(-__expf(-softplusf_(-(w0a.w + x0[3])) - 0.5f));
            d1.x = __expf(-__expf(-softplusf_(-(w0b.x + x1[0])) - 0.5f)); d1.y = __expf(-__expf(-softplusf_(-(w0b.y + x1[1])) - 0.5f));
            d1.z = __expf(-__expf(-softplusf_(-(w0b.z + x1[2])) - 0.5f)); d1.w = __expf(-__expf(-softplusf_(-(w0b.w + x1[3])) - 0.5f));
            *(float4*)(sW + o) = d0; *(float4*)(sW + o + 4) = d1;
            asm volatile("" ::: "memory"); __builtin_amdgcn_sched_barrier(0);
          }
      }
    } else if (u.pn == 1) {
#pragma unroll
      for (int bj = 0; bj < 2; ++bj) {
        const int c8 = bj * 128 + wc * 32 + 8 * fq;
        const float4 a0a = *(const float4*)(a0 + c8), a0b = *(const float4*)(a0 + c8 + 4);
        const float4 kaa = *(const float4*)(k_a + c8), kab = *(const float4*)(k_a + c8 + 4);
        const float4 kwa = *(const float4*)(k_k + c8), kwb = *(const float4*)(k_k + c8 + 4);
#pragma unroll
        for (int ai = 0; ai < 2; ++ai) {
          f32x4 kq0[4], kq1[4]; float invq[4];
#pragma unroll
          for (int m = 0; m < 4; ++m) {
            const unsigned row = (unsigned)EPI_ROWS(ai, m);
            kq0[m] = *(const f32x4*)((const char*)zk + (row * 256u + c8) * 4u); kq1[m] = *(const f32x4*)((const char*)zk + (row * 256u + c8) * 4u + 16);
            invq[m] = invn[row * 4u + (c8 >> 6)];
          }
#pragma unroll
          for (int m = 0; m < 4; ++m) {
            const unsigned o2 = ((unsigned)EPI_ROWS(ai, m) * 256u + c8) * 2u;
            const f32x4 k0 = kq0[m], k1 = kq1[m]; const float inv = invq[m];
            const f32x4 x0 = acc[ai][bj][m][0], x1 = acc[ai][bj][m][1];
            f32x4 kk0, kk1;
            kk0[0] = k0[0] * kwa.x * inv; kk0[1] = k0[1] * kwa.y * inv; kk0[2] = k0[2] * kwa.z * inv; kk0[3] = k0[3] * kwa.w * inv;
            kk1[0] = k1[0] * kwb.x * inv; kk1[1] = k1[1] * kwb.y * inv; kk1[2] = k1[2] * kwb.z * inv; kk1[3] = k1[3] * kwb.w * inv;
            f32x4 av0, av1, kka0, kka1, kp0, kp1;
            av0[0] = sigmoidf_(a0a.x + x0[0]); av0[1] = sigmoidf_(a0a.y + x0[1]); av0[2] = sigmoidf_(a0a.z + x0[2]); av0[3] = sigmoidf_(a0a.w + x0[3]);
            av1[0] = sigmoidf_(a0b.x + x1[0]); av1[1] = sigmoidf_(a0b.y + x1[1]); av1[2] = sigmoidf_(a0b.z + x1[2]); av1[3] = sigmoidf_(a0b.w + x1[3]);
            kka0 = kk0 * av0; kka1 = kk1 * av1;
            kp0[0] = k0[0] * (1.f + (av0[0] - 1.f) * kaa.x); kp0[1] = k0[1] * (1.f + (av0[1] - 1.f) * kaa.y);
            kp0[2] = k0[2] * (1.f + (av0[2] - 1.f) * kaa.z); kp0[3] = k0[3] * (1.f + (av0[3] - 1.f) * kaa.w);
            kp1[0] = k1[0] * (1.f + (av1[0] - 1.f) * kab.x); kp1[1] = k1[1] * (1.f + (av1[1] - 1.f) * kab.y);
            kp1[2] = k1[2] * (1.f + (av1[2] - 1.f) * kab.z); kp1[3] = k1[3] * (1.f + (av1[3] - 1.f) * kab.w);
            *(uint4*)((char*)sKKA + o2) = pack8(kka0, kka1); *(uint4*)((char*)sKP + o2) = pack8(kp0, kp1);
          }
          asm volatile("" ::: "memory"); __builtin_amdgcn_sched_barrier(0);
        }
      }
    } else {
#pragma unroll
      for (int bj = 0; bj < 2; ++bj) {
        const int c8 = bj * 128 + wc * 32 + 8 * fq;
#pragma unroll
        for (int ai = 0; ai < 2; ++ai)
#pragma unroll
          for (int m = 0; m < 4; ++m) {
            const size_t o = (size_t)EPI_ROWS(ai, m) * 256 + c8;
            *(uint4*)(sG + o) = pack8(acc[ai][bj][m][0], acc[ai][bj][m][1]);
          }
      }
    }
  }
};
template <int MODE>
struct EpiMerge {
  float* tmp; u16* merged; const u16* gates;
  DI void operator()(const Acc8& acc, const pg8::Unit& u, int wr, int wc, int fr, int fq) const {
    const unsigned r0 = (unsigned)(u.pm * 256 + wr * 64 + fr), c0 = (unsigned)(u.pn * 256 + wc * 32 + 8 * fq);
#pragma unroll
    for (int bj = 0; bj < 2; ++bj)
#pragma unroll
      for (int ai = 0; ai < 2; ++ai) {
        uint4 gu[4]; f32x4 t0[4], t1[4];
#pragma unroll
        for (int m = 0; m < 4; ++m) {
          const unsigned row = r0 + ai * 128 + m * 16, col = c0 + bj * 128;
          gu[m] = *(const uint4*)((const char*)gates + (row * 3072u + col) * 2u);
          if (MODE >= 1) { const char* tp = (const char*)tmp + (row * 1024u + col) * 4u; t0[m] = *(const f32x4*)(tp); t1[m] = *(const f32x4*)(tp + 16); }
        }
#pragma unroll
        for (int m = 0; m < 4; ++m) {
          const unsigned row = r0 + ai * 128 + m * 16, col = c0 + bj * 128;
          f32x4 v0 = acc[ai][bj][m][0] * unpack4(make_uint2(gu[m].x, gu[m].y));
          f32x4 v1 = acc[ai][bj][m][1] * unpack4(make_uint2(gu[m].z, gu[m].w));
          if (MODE >= 1) { v0 += t0[m]; v1 += t1[m]; }
          if (MODE <= 1) { char* tp = (char*)tmp + (row * 1024u + col) * 4u; *(f32x4*)(tp) = v0; *(f32x4*)(tp + 16) = v1; }
          else *(uint4*)((char*)merged + (row * 1024u + col) * 2u) = pack8(v0, v1);
        }
        asm volatile("" ::: "memory"); __builtin_amdgcn_sched_barrier(0);
      }
  }
};
template <int ACT>
struct EpiStore {
  u16* O; int ldc;
  DI void operator()(const Acc8& acc, const pg8::Unit& u, int wr, int wc, int fr, int fq) const {
#pragma unroll
    for (int ai = 0; ai < 2; ++ai)
#pragma unroll
      for (int m = 0; m < 4; ++m) {
        u16* rowp = O + (size_t)EPI_ROWS(ai, m) * ldc;
#pragma unroll
        for (int bj = 0; bj < 2; ++bj) {
          f32x4 v0 = acc[ai][bj][m][0], v1 = acc[ai][bj][m][1];
          if (ACT == 1) {
#pragma unroll
            for (int e = 0; e < 4; ++e) { const float r0 = fmaxf(v0[e], 0.f), r1 = fmaxf(v1[e], 0.f); v0[e] = r0 * r0; v1[e] = r1 * r1; }
          }
          *(uint4*)(rowp + EPI_COL8(bj)) = pack8(v0, v1);
        }
      }
  }
};

template <int MAP> DI int col_map(int n) {
  if (MAP == 1) {
    if (n < 1792) return n;
    if (n < 2496) return 1796 + (n - 1792);
    if (n < 2500) return 1792 + (n - 2496);
    if (n < 2560) return -1;
    return 2500 + (n - 2560);
  }
  if (MAP == 2) {
    const int h = n / 192, d = n - h * 192;
    if (d < 128) return n;
    const int j = d - 128, g = j >> 3, r = j & 7;
    return h * 192 + 128 + ((r < 4) ? (4 * g + r) : (32 + 4 * g + (r - 4)));
  }
  return n;
}
template <int MAP>
DI void conv_weight(float* ldsf, const float* __restrict__ src, u16* __restrict__ dst, const float* __restrict__ gain, int K, int N, int Npad, int bid, int nblk, int wid_k) {
  const int tid = otid(); const int tk = K >> 6; const int cnt = tk * (Npad >> 6);
  for (int it = bid; it < cnt; it += nblk) {
    const int kt = it % tk, nt = it / tk; const int k0 = kt * 64, n0 = nt * 64;
    __syncthreads();
    {
      const int nn = tid & 63; int n = col_map<MAP>(n0 + nn); if (n >= N) n = -1;
#pragma unroll 4
      for (int r = 0; r < 8; ++r) {
        const int kk = r * 8 + (tid >> 6);
        float v = 0.f;
        if (n >= 0) { v = src[(size_t)(k0 + kk) * N + n]; if (gain) v *= gain[k0 + kk]; }
        ldsf[kk * 65 + nn] = v;
      }
    }
    __syncthreads();
    {
      const int nn = tid >> 3, kb = (tid & 7) * 8;
      uint4 o;
      o.x = pack2(ldsf[(kb + 0) * 65 + nn], ldsf[(kb + 1) * 65 + nn]); o.y = pack2(ldsf[(kb + 2) * 65 + nn], ldsf[(kb + 3) * 65 + nn]);
      o.z = pack2(ldsf[(kb + 4) * 65 + nn], ldsf[(kb + 5) * 65 + nn]); o.w = pack2(ldsf[(kb + 6) * 65 + nn], ldsf[(kb + 7) * 65 + nn]);
      *(uint4*)(dst + (size_t)(n0 + nn) * K + k0 + kb) = o;
    }
  }
}

DI void rowwise_phase(const float* __restrict__ xin, float* __restrict__ xout, const u16* __restrict__ tbuf,
                      const float* __restrict__ gate, const float* __restrict__ pgain,
                      const float* __restrict__ pre_gain, const float* __restrict__ sc, const float* __restrict__ sh, u16* __restrict__ hbuf, int bid, int nblk, int wid_k) {
  const int tid = otid(); const int lane = tid & 63;
  const int gw = bid * 8 + (tid >> 6), nw = nblk * 8;
  for (int row = gw; row < T; row += nw) {
    const int b = row >> 12;
    float4 xv[4];
#pragma unroll
    for (int i = 0; i < 4; ++i) { const f32x4 t_ = __builtin_nontemporal_load((const f32x4*)(xin + (size_t)row * 1024 + i * 256 + lane * 4)); xv[i] = make_float4(t_[0], t_[1], t_[2], t_[3]); }
    if (tbuf) {
      float4 tv[4]; float ss = 0.f;
#pragma unroll
      for (int i = 0; i < 4; ++i) {
        typedef unsigned u32x2_ __attribute__((ext_vector_type(2)));
        const u32x2_ u_ = __builtin_nontemporal_load((const u32x2_*)(tbuf + (size_t)row * 1024 + i * 256 + lane * 4)); const uint2 u = make_uint2(u_[0], u_[1]);
        tv[i] = make_float4(bflo(u.x), bfhi(u.x), bflo(u.y), bfhi(u.y));
        ss += tv[i].x * tv[i].x + tv[i].y * tv[i].y + tv[i].z * tv[i].z + tv[i].w * tv[i].w;
      }
      ss = wave_sum(ss);
      const float rstd = rsqrtf(ss * (1.f / 1024.f) + 1e-6f);
#pragma unroll
      for (int i = 0; i < 4; ++i) {
        const int c = i * 256 + lane * 4;
        const float4 g = *(const float4*)(gate + (size_t)b * 6144 + c);
        const float4 pg = *(const float4*)(pgain + c);
        xv[i].x += g.x * (tv[i].x * rstd) * pg.x; xv[i].y += g.y * (tv[i].y * rstd) * pg.y;
        xv[i].z += g.z * (tv[i].z * rstd) * pg.z; xv[i].w += g.w * (tv[i].w * rstd) * pg.w;
      }
    }
#pragma unroll
    for (int i = 0; i < 4; ++i) { const f32x4 t_ = {xv[i].x, xv[i].y, xv[i].z, xv[i].w}; __builtin_nontemporal_store(t_, (f32x4*)(xout + (size_t)row * 1024 + i * 256 + lane * 4)); }
    if (hbuf) {
      float ss = 0.f;
#pragma unroll
      for (int i = 0; i < 4; ++i) ss += xv[i].x * xv[i].x + xv[i].y * xv[i].y + xv[i].z * xv[i].z + xv[i].w * xv[i].w;
      ss = wave_sum(ss);
      const float rstd = rsqrtf(ss * (1.f / 1024.f) + 1e-6f);
#pragma unroll
      for (int i = 0; i < 4; ++i) {
        const int c = i * 256 + lane * 4;
        const float4 g = *(const float4*)(pre_gain + c);
        const float4 s1 = *(const float4*)(sc + (size_t)b * 6144 + c);
        const float4 s0 = *(const float4*)(sh + (size_t)b * 6144 + c);
        f32x4 h;
        h[0] = xv[i].x * rstd * g.x * (1.f + s1.x) + s0.x; h[1] = xv[i].y * rstd * g.y * (1.f + s1.y) + s0.y;
        h[2] = xv[i].z * rstd * g.z * (1.f + s1.z) + s0.z; h[3] = xv[i].w * rstd * g.w * (1.f + s1.w) + s0.w;
        *(uint2*)(hbuf + (size_t)row * 1024 + c) = pack4(h);
      }
    }
  }
}

DI f32x4 sm4(const u16* __restrict__ z, const float* __restrict__ mu, int t, int c) {
  const uint2 cu = *(const uint2*)(z + (size_t)t * 1024 + c);
  uint2 pr = make_uint2(0u, 0u);
  if (t & (SEQ - 1)) pr = *(const uint2*)(z + (size_t)(t - 1) * 1024 + c);
  const float4 m = *(const float4*)(mu + c);
  const float x0 = bflo(cu.x), x1 = bfhi(cu.x), x2 = bflo(cu.y), x3 = bfhi(cu.y);
  f32x4 r;
  r[0] = x0 + (bflo(pr.x) - x0) * m.x; r[1] = x1 + (bfhi(pr.x) - x1) * m.y;
  r[2] = x2 + (bflo(pr.y) - x2) * m.z; r[3] = x3 + (bfhi(pr.y) - x3) * m.w;
  return r;
}
DI float sumsq8(uint4 u) {
  float s = 0.f, x;
  x = bflo(u.x); s += x * x; x = bfhi(u.x); s += x * x; x = bflo(u.y); s += x * x; x = bfhi(u.y); s += x * x;
  x = bflo(u.z); s += x * x; x = bfhi(u.z); s += x * x; x = bflo(u.w); s += x * x; x = bfhi(u.w); s += x * x;
  return s;
}
template <int NCOLS>
DI void block_rstd(float* tab, const u16* __restrict__ A, int m0, int wid_k) {
  const int tid = otid(), row = tid >> 1, half = tid & 1;
  const uint4* src = (const uint4*)(A + (size_t)(m0 + row) * NCOLS + half * (NCOLS / 2));
  float ss = 0.f;
#pragma unroll 4
  for (int i = 0; i < NCOLS / 16; ++i) ss += sumsq8(src[i]);
  ss += __shfl_xor(ss, 1);
  if (!half) tab[row] = rsqrtf(ss * (1.f / NCOLS) + 1e-6f);
}

#define MFMA32(a, b, c) __builtin_amdgcn_mfma_f32_32x32x16_bf16((a), (b), (c), 0, 0, 0)
template <int DK, int DV, bool BIAS>
DI void attn_item(u16* lds, const u16* __restrict__ Q, const u16* __restrict__ Kg, const u16* __restrict__ VT,
                  const float* __restrict__ cum, u16* __restrict__ O, int ldo, int bh, int qb, int wid_k) {
  constexpr int KSTR = DK + 8, NKS = DK / 16, NMB = DV / 32;
  constexpr int TILE_U16_ = 64 * KSTR + DV * 72 + 128;
  const int tid = otid(), lane = tid & 63, w = tid >> 6, l31 = lane & 31, h2 = lane >> 5;
  const int qrow = qb * 256 + w * 32 + l31;
  bf16x8 qf[NKS];
  {
    const u16* qp = Q + ((size_t)bh * SEQ + qrow) * DK + h2 * 8;
#pragma unroll
    for (int ks = 0; ks < NKS; ++ks) qf[ks] = *(const bf16x8*)(qp + ks * 16);
  }
  float cq = 0.f;
  if (BIAS) cq = cum[bh * SEQ + qrow];
  f32x16 o[NMB];
#pragma unroll
  for (int mb = 0; mb < NMB; ++mb)
#pragma unroll
    for (int i = 0; i < 16; ++i) o[mb][i] = 0.f;
  float mrun = -1e30f, lrun = 0.f;
  const int wq0 = qb * 256 + w * 32;
  const int ntiles = 4 * qb + 4;
  constexpr int NKL = (64 * DK / 8) / NTHR, NVL = (DV * 8) / NTHR;
  uint4 pk0, pk1, pk2, pv0, pv1; float pc_ = 0.f;
  pk0 = pk1 = pk2 = pv0 = pv1 = make_uint4(0u, 0u, 0u, 0u);
#define AK_(i) if (i < NKL) { const int c = tid + NTHR * i; const int row = c / (DK / 8), kc = c % (DK / 8); pk##i = *(const uint4*)(kp_ + (size_t)row * DK + kc * 8); }
#define AV_(i) if (i < NVL) { const int c = tid + NTHR * i; const int row = c >> 3, kc = c & 7; pv##i = *(const uint4*)(vp_ + (size_t)row * SEQ + kc * 8); }
#define ATT_ISSUE(k0_) do { const u16* kp_ = Kg + ((size_t)bh * SEQ + (k0_)) * DK; const u16* vp_ = VT + (size_t)bh * DV * SEQ + (k0_); \
    AK_(0) AK_(1) AK_(2) AV_(0) AV_(1) \
    if (BIAS) { if (tid < 64) pc_ = cum[bh * SEQ + (k0_) + tid]; } } while (0)
#define SK_(i) if (i < NKL) { const int c = tid + NTHR * i; const int row = c / (DK / 8), kc = c % (DK / 8); *(uint4*)(wK + row * KSTR + kc * 8) = pk##i; }
#define SV_(i) if (i < NVL) { const int c = tid + NTHR * i; const int row = c >> 3, kc = c & 7; *(uint4*)(wV + row * 72 + kc * 8) = pv##i; }
#define ATT_COMMIT(b_) do { u16* wK = lds + (b_) * TILE_U16_; u16* wV = wK + 64 * KSTR; float* wC = (float*)(wV + DV * 72); \
    SK_(0) SK_(1) SK_(2) SV_(0) SV_(1) if (BIAS) { if (tid < 64) wC[tid] = pc_; } } while (0)
  __syncthreads();
  ATT_ISSUE(0);
  ATT_COMMIT(0);
  if (ntiles > 1) ATT_ISSUE(64);
  for (int kt = 0; kt < ntiles; ++kt) {
    const int k0 = kt * 64;
    __syncthreads();
    if (kt + 1 < ntiles) { ATT_COMMIT((kt + 1) & 1); if (kt + 2 < ntiles) ATT_ISSUE(k0 + 128); }
    const u16* ldsK = lds + (kt & 1) * TILE_U16_; const u16* ldsV = ldsK + 64 * KSTR; const float* ldsC = (const float*)(ldsV + DV * 72);
#pragma unroll
    for (int kh = 0; kh < 2; ++kh) {
      const int kb = k0 + kh * 32;
      if (kb > wq0 + 31) continue;
      f32x16 st;
#pragma unroll
      for (int i = 0; i < 16; ++i) st[i] = 0.f;
#pragma unroll
      for (int ks = 0; ks < NKS; ++ks) {
        const bf16x8 kf = *(const bf16x8*)(ldsK + (kh * 32 + l31) * KSTR + ks * 16 + h2 * 8);
        st = MFMA32(kf, qf[ks], st);
      }
      if (BIAS) {
#pragma unroll
        for (int g = 0; g < 4; ++g) {
          const float4 ck = *(const float4*)(ldsC + kh * 32 + 8 * g + 4 * h2);
          st[4 * g + 0] += cq - ck.x; st[4 * g + 1] += cq - ck.y; st[4 * g + 2] += cq - ck.z; st[4 * g + 3] += cq - ck.w;
        }
      }
      if (kb + 31 > wq0) {
#pragma unroll
        for (int i = 0; i < 16; ++i) {
          const int key = kb + (i & 3) + 8 * (i >> 2) + 4 * h2;
          if (key > qrow) st[i] = -1e30f;
        }
      }
      float mx = st[0];
#pragma unroll
      for (int i = 1; i < 16; ++i) mx = fmaxf(mx, st[i]);
      { auto r_ = __builtin_amdgcn_permlane32_swap(__float_as_uint(mx), __float_as_uint(mx), false, false); mx = fmaxf(__uint_as_float(r_[0]), __uint_as_float(r_[1])); }
      const float mnew = fmaxf(mrun, mx);
      const float alpha = __builtin_amdgcn_exp2f(mrun - mnew);
      const bool resc = __builtin_amdgcn_ballot_w64(mnew > mrun) != 0ull;
      mrun = mnew;
      float ps = 0.f;
#pragma unroll
      for (int i = 0; i < 16; ++i) { st[i] = __builtin_amdgcn_exp2f(st[i] - mnew); ps += st[i]; }
      lrun = lrun * alpha + ps;
      if (resc) {
#pragma unroll
        for (int mb = 0; mb < NMB; ++mb)
#pragma unroll
          for (int i = 0; i < 16; ++i) o[mb][i] *= alpha;
      }
      bf16x8 pf[2];
#pragma unroll
      for (int s = 0; s < 2; ++s) {
        uint4 pk;
        pk.x = pack2(st[8 * s + 0], st[8 * s + 1]); pk.y = pack2(st[8 * s + 2], st[8 * s + 3]);
        pk.z = pack2(st[8 * s + 4], st[8 * s + 5]); pk.w = pack2(st[8 * s + 6], st[8 * s + 7]);
        pf[s] = __builtin_bit_cast(bf16x8, pk);
      }
#pragma unroll
      for (int mb = 0; mb < NMB; ++mb)
#pragma unroll
        for (int s = 0; s < 2; ++s) {
          const u16* vpp = ldsV + (mb * 32 + l31) * 72 + kh * 32 + 16 * s + 4 * h2;
          const s16x4 lo = *(const s16x4*)(vpp);
          const s16x4 hi = *(const s16x4*)(vpp + 8);
          const bf16x8 vf = __builtin_shufflevector(lo, hi, 0, 1, 2, 3, 4, 5, 6, 7);
          o[mb] = MFMA32(vf, pf[s], o[mb]);
        }
    }
  }
#undef AK_
#undef AV_
#undef ATT_ISSUE
#undef SK_
#undef SV_
#undef ATT_COMMIT
  { auto r_ = __builtin_amdgcn_permlane32_swap(__float_as_uint(lrun), __float_as_uint(lrun), false, false); lrun = __uint_as_float(r_[0]) + __uint_as_float(r_[1]); }
  const float inv = 1.f / lrun;
  const int b = bh >> 2, h = bh & 3;
  u16* op = O + ((size_t)b * SEQ + qrow) * ldo + h * DV;
#pragma unroll
  for (int mb = 0; mb < NMB; ++mb)
#pragma unroll
    for (int g = 0; g < 4; ++g) {
      f32x4 v;
      v[0] = o[mb][4 * g + 0] * inv; v[1] = o[mb][4 * g + 1] * inv; v[2] = o[mb][4 * g + 2] * inv; v[3] = o[mb][4 * g + 3] * inv;
      *(uint2*)(op + mb * 32 + 8 * g + 4 * h2) = pack4(v);
    }
}

DI void scan_block(float* ldsf, const u16* __restrict__ R, const u16* __restrict__ KP, const u16* __restrict__ KK, const u16* __restrict__ KKA,
                   const u16* __restrict__ V, const float* __restrict__ Wd, float* __restrict__ Y, int blk, int wid_k) {
  const int tid = otid(), lane = tid & 63, w = tid >> 6;
  const int bh = blk >> 2, rq = blk & 3, b = bh >> 2, h = bh & 3;
  const int ks = lane & 15, rowl = (w & 3) * 4 + (lane >> 4);
  const bool worker = (w < 4);
  float* ybuf = ldsf + 2 * 16 * 336;
  float S0 = 0.f, S1 = 0.f, S2 = 0.f, S3 = 0.f, yreg = 0.f;
  const size_t tb = (size_t)b * SEQ;
  const int hc = h * 64;
  const int a0i = tid >> 7, a0step = (tid & 127) >> 3, a0c = (tid & 7) * 8;
  const int wstep = (tid & 255) >> 4, wc = (tid & 15) * 4;
  const int vstep = (tid & 31) >> 1, vhalf = tid & 1;
  uint4 p0, pv; float4 pw;
  p0 = pv = make_uint4(0u, 0u, 0u, 0u); pw = make_float4(0.f, 0.f, 0.f, 0.f);
#define SCAN_ISSUE(c_) do { \
    const size_t t0_ = tb + (size_t)(c_) * 16; \
    const u16* s0_ = (a0i == 0 ? KK : (a0i == 1 ? KKA : (a0i == 2 ? KP : R))); \
    p0 = *(const uint4*)(s0_ + (t0_ + a0step) * 256 + hc + a0c); \
    if (tid < 256) pw = *(const float4*)(Wd + (t0_ + wstep) * 256 + hc + wc); \
    if (tid >= 256 && tid < 288) pv = *(const uint4*)(V + (t0_ + vstep) * 256 + hc + rq * 16 + vhalf * 8); \
  } while (0)
#define SCAN_COMMIT(bufi_) do { \
    float* bp_ = ldsf + (bufi_) * 16 * 336; \
    float* d0_ = bp_ + a0step * 336 + 64 + a0i * 64 + a0c; \
    *(float4*)(d0_) = make_float4(bflo(p0.x), bfhi(p0.x), bflo(p0.y), bfhi(p0.y)); \
    *(float4*)(d0_ + 4) = make_float4(bflo(p0.z), bfhi(p0.z), bflo(p0.w), bfhi(p0.w)); \
    if (tid < 256) *(float4*)(bp_ + wstep * 336 + wc) = pw; \
    if (tid >= 256 && tid < 288) { \
      float* dv_ = bp_ + vstep * 336 + 320 + vhalf * 8; \
      *(float4*)(dv_) = make_float4(bflo(pv.x), bfhi(pv.x), bflo(pv.y), bfhi(pv.y)); \
      *(float4*)(dv_ + 4) = make_float4(bflo(pv.z), bfhi(pv.z), bflo(pv.w), bfhi(pv.w)); \
    } \
  } while (0)
  __syncthreads();
  SCAN_ISSUE(0);
  SCAN_COMMIT(0);
  __syncthreads();
  for (int c = 0; c < SEQ / 16; ++c) {
    const int cur = c & 1;
    if (c + 1 < SEQ / 16) SCAN_ISSUE(c + 1);
    const float* bp = ldsf + cur * 16 * 336;
    float* yb = ybuf + cur * 256;
    if (worker) {
      typedef float f2 __attribute__((ext_vector_type(2)));
      f2 Sa = {S0, S1}, Sb = {S2, S3};
      float4 w4 = *(const float4*)(bp + ks * 4);
      float4 kk4 = *(const float4*)(bp + 64 + ks * 4);
      float4 ka4 = *(const float4*)(bp + 128 + ks * 4);
      float4 kp4 = *(const float4*)(bp + 192 + ks * 4);
      float4 r4 = *(const float4*)(bp + 256 + ks * 4);
      float vv = bp[320 + rowl];
      float yp = 0.f;
#pragma unroll
      for (int step = 0; step < 16; ++step) {
        float4 w4n = w4, kk4n = kk4, ka4n = ka4, kp4n = kp4, r4n = r4; float vvn = vv;
        if (step + 1 < 16) {
          const float* sp = bp + (step + 1) * 336;
          w4n = *(const float4*)(sp + ks * 4);
          kk4n = *(const float4*)(sp + 64 + ks * 4);
          ka4n = *(const float4*)(sp + 128 + ks * 4);
          kp4n = *(const float4*)(sp + 192 + ks * 4);
          r4n = *(const float4*)(sp + 256 + ks * 4);
          vvn = sp[320 + rowl];
        }
        const f2 kka = {kk4.x, kk4.y}, kkb = {kk4.z, kk4.w}, wa = {w4.x, w4.y}, wb = {w4.z, w4.w};
        const f2 kaa = {ka4.x, ka4.y}, kab = {ka4.z, ka4.w}, kpa = {kp4.x, kp4.y}, kpb = {kp4.z, kp4.w};
        const f2 ra = {r4.x, r4.y}, rb = {r4.z, r4.w};
        const f2 d2 = Sa * kka + Sb * kkb;
        float d = d2.x + d2.y;
        const f2 ta = Sa * wa + kpa * vv, tb = Sb * wb + kpb * vv;
        d = dpp_add<0xB1>(d); yp = dpp_add<0xB1>(yp);
        d = dpp_add<0x4E>(d); yp = dpp_add<0x4E>(yp);
        d = dpp_add<0x141>(d); yp = dpp_add<0x141>(yp);
        d = dpp_add<0x140>(d); yp = dpp_add<0x140>(yp);
        if (step > 0) yreg = (ks == step - 1) ? yp : yreg;
        Sa = ta - kaa * d; Sb = tb - kab * d;
        const f2 y2 = Sa * ra + Sb * rb;
        yp = y2.x + y2.y;
        w4 = w4n; kk4 = kk4n; ka4 = ka4n; kp4 = kp4n; r4 = r4n; vv = vvn;
      }
      yp = reduce16(yp);
      yreg = (ks == 15) ? yp : yreg;
      S0 = Sa.x; S1 = Sa.y; S2 = Sb.x; S3 = Sb.y;
      yb[ks * 16 + rowl] = yreg;
    }
    if (c + 1 < SEQ / 16) SCAN_COMMIT(cur ^ 1);
    __syncthreads();
    if (tid < 256) {
      const int step = tid >> 4, row = tid & 15;
      Y[(tb + (size_t)c * 16 + step) * 256 + hc + rq * 16 + row] = yb[tid];
    }
  }
  __syncthreads();
#undef SCAN_ISSUE
#undef SCAN_COMMIT
}

#define XB_TMO      128
#define XB_XCNT(j)  (256  + 64 * (j))
#define XB_XSUB(j)  (1280 + 64 * (j))
#define XB_XGEN(j)  (2304 + 64 * (j))
#define XB_TOP      3328
#define XB_TOPGEN   3392
#define XCD_BAR_WORDS 3456
#define XB_SPIN_CAP (1u << 22)
DI unsigned xb_ld(unsigned* p)              { return __hip_atomic_load(p, __ATOMIC_RELAXED, __HIP_MEMORY_SCOPE_AGENT); }
DI unsigned xb_add(unsigned* p, unsigned v) { return __hip_atomic_fetch_add(p, v, __ATOMIC_RELAXED, __HIP_MEMORY_SCOPE_AGENT); }
DI unsigned xb_xcc_id() { return (unsigned)__builtin_amdgcn_s_getreg((3 << 11) | 20) & 0xFu; }
#define XB_SPIN(cond, bar) do { unsigned _sp = 0; while (cond) { __builtin_amdgcn_s_sleep(1); \
    if ((++_sp & 255u) == 0u) { if (xb_ld(&(bar)[XB_TMO])) break; if (_sp > XB_SPIN_CAP) { atomicAdd(&(bar)[XB_TMO], 1u); break; } } } } while (0)
struct XcdBarrier { unsigned* bar; unsigned x; volatile LAS unsigned* st; };
DI XcdBarrier xcd_barrier_post(unsigned* bar, volatile LAS unsigned* st, int wid_k) {
    XcdBarrier b; b.bar = bar; b.x = xb_xcc_id(); b.st = st;
    if (otid() == 0) (void)xb_add(&bar[XB_XCNT(b.x)], 1u);
    return b;
}
DI void xcd_barrier_complete(unsigned* bar, unsigned x, unsigned& nloc, unsigned& nx) {
    const unsigned G = gridDim.x * gridDim.y * gridDim.z;
    unsigned sum, cnt, mine, sp = 0u;
    for (;;) {
        sum = 0u; cnt = 0u; mine = 0u;
#pragma unroll
        for (unsigned j = 0; j < 16; ++j) { const unsigned c = xb_ld(&bar[XB_XCNT(j)]); sum += c; cnt += (c > 0u) ? 1u : 0u; mine = (j == x) ? c : mine; }
        if (sum == G) break;
        __builtin_amdgcn_s_sleep(1);
        if ((++sp & 255u) == 0u) { if (xb_ld(&bar[XB_TMO])) break; if (sp > XB_SPIN_CAP) { atomicAdd(&bar[XB_TMO], 1u); break; } }
    }
    nloc = mine > 0u ? mine : 1u; nx = cnt > 0u ? cnt : 1u;
}
DI void xcd_barrier(const XcdBarrier& b, int wid_k) {
    asm volatile("s_waitcnt vmcnt(0)" ::: "memory");
    __syncthreads();
    if (otid() == 0) {
        unsigned* bar = b.bar;
        __builtin_amdgcn_s_waitcnt(0);
        unsigned nloc = b.st[0], nx = b.st[1];
        if (nloc == 0u) { xcd_barrier_complete(bar, b.x, nloc, nx); b.st[0] = nloc; b.st[1] = nx; }
        const unsigned old = xb_add(&bar[XB_XSUB(b.x)], 1u);
        const unsigned gen = old / nloc;
        if (old + 1u == (gen + 1u) * nloc) {
            __builtin_amdgcn_fence(__ATOMIC_RELEASE, "agent");
            asm volatile("s_waitcnt vmcnt(0)" ::: "memory");
            const unsigned og = xb_add(&bar[XB_TOP], 1u);
            const unsigned tg = og / nx;
            if (og + 1u == (tg + 1u) * nx) xb_add(&bar[XB_TOPGEN], 1u);
            else XB_SPIN(xb_ld(&bar[XB_TOPGEN]) == tg, bar);
            __builtin_amdgcn_fence(__ATOMIC_ACQUIRE, "agent");
            xb_add(&bar[XB_XGEN(b.x)], 1u);
            asm volatile("s_waitcnt vmcnt(0)" ::: "memory");
        } else {
            XB_SPIN(xb_ld(&bar[XB_XGEN(b.x)]) == gen, bar);
            __builtin_amdgcn_fence(__ATOMIC_ACQUIRE, "agent");
            asm volatile("s_waitcnt vmcnt(0)" ::: "memory");
        }
    }
    __syncthreads();
}

#define GAS __attribute__((address_space(1)))

DI bool bid_is_scan(unsigned b) { return b < 64u; }
DI void sub_barrier(unsigned* w, unsigned need, int wid_k) {
    asm volatile("s_waitcnt vmcnt(0)" ::: "memory");
    __syncthreads();
    if (otid() == 0) {
        __builtin_amdgcn_fence(__ATOMIC_RELEASE, "agent");
        asm volatile("s_waitcnt vmcnt(0)" ::: "memory");
        (void)xb_add(w, 1u);
        unsigned sp = 0u;
        while (xb_ld(w) < need) { __builtin_amdgcn_s_sleep(2); if (++sp > (1u << 24)) break; }
        __builtin_amdgcn_fence(__ATOMIC_ACQUIRE, "agent");
        asm volatile("s_waitcnt vmcnt(0)" ::: "memory");
    }
    __syncthreads();
}
DI void sub_wait(unsigned* w, unsigned need, int wid_k) {
    __syncthreads();
    if (otid() == 0) {
        unsigned sp = 0u;
        while (xb_ld(w) < need) { __builtin_amdgcn_s_sleep(8); if (++sp > (1u << 24)) break; }
        __builtin_amdgcn_fence(__ATOMIC_ACQUIRE, "agent");
        asm volatile("s_waitcnt vmcnt(0)" ::: "memory");
    }
    __syncthreads();
}
#define GAS __attribute__((address_space(1)))
#define PHASE_BEGIN() size_t oz_ = 0; asm volatile("" : "+s"(oz_)); int oi_ = 0; asm volatile("" : "+s"(oi_)); GAS unsigned char* wsg_ = (GAS unsigned char*)p.ws; asm volatile("" : "+s"(wsg_)); unsigned char* const ws = (unsigned char*)wsg_; (void)ws; \
  const int tid = otid(); const int lane = tid & 63, wv = tid >> 6; \
  int bid = blockIdx.x; asm volatile("" : "+s"(bid)); int nblk = gridDim.x; asm volatile("" : "+s"(nblk)); \
  const int gtid = bid * NTHR + tid, gthreads = nblk * NTHR; (void)lane; (void)wv; (void)gtid; (void)gthreads
#define INP(TY, i) ((const TY*)((const char*)(p.in[(i) + oi_]) + oz_))
#define OUTP() ((float*)((char*)(p.out) + oz_))
#define WSP(TY, off) ((TY*)(ws + (off)))
#define GSYNC() do { XcdBarrier xb_; xb_.bar = (unsigned*)(p.ws + OFF_CTL); xb_.x = xb_xcc_id(); xb_.st = (volatile LAS unsigned*)(lds_raw + LDS_MISC + 4096); xcd_barrier(xb_, wid_k); } while (0)
#define CONVERT_LAYER(lc_, wselc_) do { \
    conv_weight<1>(ldsf, INP(float, 3) + (size_t)lc_ * 1024 * 5572, WSP(u16, OFF_WIN + wselc_), nullptr, 1024, 5572, INP, bid, nblk, wid_k); \
    conv_weight<2>(ldsf, INP(float, 17) + (size_t)lc_ * 384 * 768, WSP(u16, OFF_WQ + wselc_), INP(float, 16) + lc_ * 384, 384, 768, 768, bid, nblk, wid_k); \
    conv_weight<0>(ldsf, INP(float, 19) + (size_t)lc_ * 256 * 1024, WSP(u16, OFF_WKV + wselc_), INP(float, 18) + lc_ * 256, 256, 1024, 1024, bid, nblk, wid_k); \
    conv_weight<0>(ldsf, INP(float, 20) + (size_t)lc_ * 256 * 1024, WSP(u16, OFF_WA + wselc_), nullptr, 256, 1024, 1024, bid, nblk, wid_k); \
    conv_weight<0>(ldsf, INP(float, 21) + (size_t)lc_ * 256 * 1024, WSP(u16, OFF_WB + wselc_), nullptr, 256, 1024, 1024, bid, nblk, wid_k); \
    conv_weight<0>(ldsf, INP(float, 22) + (size_t)lc_ * 512 * 1024, WSP(u16, OFF_WC + wselc_), nullptr, 512, 1024, 1024, bid, nblk, wid_k); \
    conv_weight<0>(ldsf, INP(float, 23) + (size_t)lc_ * 1024 * 1024, WSP(u16, OFF_WOUT + wselc_), nullptr, 1024, 1024, 1024, bid, nblk, wid_k); \
    conv_weight<0>(ldsf, INP(float, 30) + (size_t)lc_ * 1024 * 4096, WSP(u16, OFF_WUP + wselc_), nullptr, 1024, 4096, 4096, bid, nblk, wid_k); \
    conv_weight<0>(ldsf, INP(float, 31) + (size_t)lc_ * 4096 * 1024, WSP(u16, OFF_WDN + wselc_), nullptr, 4096, 1024, 1024, bid, nblk, wid_k); \
    { \
      const float* wd = INP(float, 6) + (size_t)lc_ * 64 * 256; const float* wa = INP(float, 8) + (size_t)lc_ * 64 * 256; const float* wg = INP(float, 9) + (size_t)lc_ * 128 * 256; \
      u16* wl = WSP(u16, OFF_WLORA + wselc_); \
      for (int i = gtid; i < 768 * 256; i += gthreads) { \
        const int n = i >> 8, k = i & 255; float v = 0.f; \
        if (n < 256) { if (k < 64) v = wd[k * 256 + n]; } \
        else if (n < 512) { if (k >= 64 && k < 128) v = wa[(k - 64) * 256 + (n - 256)]; } \
        else { if (k >= 128) v = wg[(k - 128) * 256 + (n - 512)]; } \
        wl[i] = f2bf(v); \
      } \
    } \
  } while (0)
__global__ void __launch_bounds__(NTHR, 2) fwd_kernel(Params p) {
  extern __shared__ __attribute__((aligned(16))) unsigned char lds_raw[];
  cg::grid_group grid = cg::this_grid();
  u16* lds = (u16*)lds_raw;
  float* ldsf = (float*)lds_raw;
  LAS unsigned char* ldsg = (LAS unsigned char*)lds_raw;
  float* ldsmisc = (float*)(lds_raw + LDS_MISC);
  volatile LAS unsigned* bst = (volatile LAS unsigned*)(lds_raw + LDS_MISC + 4096);
  const int wid_k = __builtin_amdgcn_readfirstlane((int)threadIdx.x >> 6);
  { const int t0_ = otid(); if (t0_ < 4) bst[t0_] = 0u; }
  __syncthreads();
  (void)xcd_barrier_post((unsigned*)(p.ws + OFF_CTL), bst, wid_k);

  {
  PHASE_BEGIN();
  const int* in_pos = INP(int, 2); const float* in_c = INP(float, 1); const float* w_mod = INP(float, 24);
  float* costab = WSP(float, OFF_COS); float* sintab = WSP(float, OFF_SIN); float* modp = WSP(float, OFF_MODP);
  for (int i = gtid; i < T * 32; i += gthreads) {
    const int t = i >> 5, f = i & 31;
    const float pos = (float)in_pos[t];
    const float invf = powf(10000.f, -(float)(2 * f) / 64.f);
    const float ang = pos * invf;
    costab[i] = cosf(ang); sintab[i] = sinf(ang);
  }
  {
    for (int i = tid; i < 4096; i += NTHR) { const float v = in_c[i]; ldsf[i] = v / (1.f + expf(-v)); }
    __syncthreads();
    for (int it = bid; it < 4 * 12 * 8; it += nblk) {
      const int l = it / 96, rem = it - l * 96, nch = rem >> 3, ks = rem & 7;
      const int n = nch * 512 + tid;
      float a0_ = 0.f, a1_ = 0.f, a2_ = 0.f, a3_ = 0.f;
      const float* wp = w_mod + ((size_t)l * 1024 + ks * 128) * 6144 + n;
#pragma unroll 8
      for (int k = 0; k < 128; ++k) {
        const float wv_ = wp[(size_t)k * 6144];
        const int kk = ks * 128 + k;
        a0_ += ldsf[kk] * wv_; a1_ += ldsf[1024 + kk] * wv_; a2_ += ldsf[2048 + kk] * wv_; a3_ += ldsf[3072 + kk] * wv_;
      }
      float* mp = modp + ((size_t)(ks * 4 + l) * 4) * 6144 + n;
      mp[0] = a0_; mp[6144] = a1_; mp[2 * 6144] = a2_; mp[3 * 6144] = a3_;
    }
  }
  }
  grid.sync();
  {
  PHASE_BEGIN();
  const float* b_mod = INP(float, 25); const float* modp = WSP(float, OFF_MODP); float* mod = WSP(float, OFF_MOD);
  for (int i = gtid; i < 4 * 4 * 6144; i += gthreads) {
    const int l = i / (4 * 6144), n = i % 6144;
    float v = b_mod[l * 6144 + n];
#pragma unroll
    for (int ks = 0; ks < 8; ++ks) v += modp[(size_t)ks * 98304 + i];
    mod[i] = v;
  }
  }
  GSYNC();

  for (int l = 0; l < 4; ++l) {
    const size_t wsel = (l & 1) ? (size_t)(WS_END - OFF_WIN) : (size_t)0;
    {
    PHASE_BEGIN();
    if (l == 0) CONVERT_LAYER(0, (size_t)0);
    const float* mod = WSP(float, OFF_MOD); const float* modl = mod + (size_t)l * 4 * 6144;
    if (l == 0)
      rowwise_phase(INP(float, 0), OUTP(), nullptr, nullptr, nullptr, INP(float, 26), modl + 1024, modl + 0, WSP(u16, OFF_HBUF), bid, nblk, wid_k);
    else
      rowwise_phase(OUTP(), OUTP(), WSP(u16, OFF_TBUF), mod + (size_t)(l - 1) * 4 * 6144 + 5120, INP(float, 29) + (l - 1) * 1024,
                    INP(float, 26) + l * 1024, modl + 1024, modl + 0, WSP(u16, OFF_HBUF), bid, nblk, wid_k);
    }
    GSYNC();

    {
    PHASE_BEGIN();
    pg8::Gemm g{WSP(u16, OFF_HBUF), WSP(u16, OFF_WIN + wsel), 1024, 1024, 1024};
    pg8::StaticOrder S; S.init(T, 1024, nblk, bid);
    EpiStore<0> E{WSP(u16, OFF_ZRAW), 1024};
    pg8::gemm_phase(ldsg, g, S, E, wid_k);
    }
    GSYNC();

    {
    PHASE_BEGIN();
    const u16* zraw = WSP(u16, OFF_ZRAW); const float* mu = INP(float, 4) + l * 1024; const float* k_k = INP(float, 10) + l * 256;
    u16* sR = WSP(u16, OFF_SR); u16* sV = WSP(u16, OFF_SV); u16* sKK = WSP(u16, OFF_SKK); float* zk = WSP(float, OFF_ZK); float* invn = WSP(float, OFF_INVN); u16* zl = WSP(u16, OFF_ZL);
    const int c = lane * 4;
    const float4 kkw = *(const float4*)(k_k + c);
    for (int t = bid * 8 + wv; t < T; t += nblk * 8) {
      const size_t o = (size_t)t * 256 + c;
      const f32x4 r = sm4(zraw, mu, t, c), k = sm4(zraw, mu, t, 256 + c), v = sm4(zraw, mu, t, 512 + c);
      f32x4 lo = sm4(zraw, mu, t, 768 + c);
      f32x4 kk; kk[0] = k[0] * kkw.x; kk[1] = k[1] * kkw.y; kk[2] = k[2] * kkw.z; kk[3] = k[3] * kkw.w;
      const float ss = reduce16(kk[0] * kk[0] + kk[1] * kk[1] + kk[2] * kk[2] + kk[3] * kk[3]);
      const float inv = 1.f / fmaxf(sqrtf(ss), 1e-12f);
      kk *= inv;
      if ((lane & 15) == 0) invn[(size_t)t * 4 + (lane >> 4)] = inv;
      if (c < 64) {
#pragma unroll
        for (int e = 0; e < 4; ++e) lo[e] = tanhf(lo[e]);
      } else if (c >= 128) {
#pragma unroll
        for (int e = 0; e < 4; ++e) lo[e] = sigmoidf_(lo[e]);
      }
      *(uint2*)(sR + o) = pack4(r); *(f32x4*)(zk + o) = k; *(uint2*)(sV + o) = pack4(v);
      *(uint2*)(sKK + o) = pack4(kk); *(uint2*)(zl + o) = pack4(lo);
    }
    }
    GSYNC();

    {
    PHASE_BEGIN();
    if (bid >= 64) {
      pg8::StaticOrder S0; S0.init(T, 768, 192, bid - 64);
      pg8::Unit u0; const bool ok0 = S0.next(0, u0);
      int pm_ = u0.pm, pn_ = u0.pn; asm volatile("" : "+s"(pm_), "+s"(pn_));
      pg8::OneUnit S{pm_, pn_, ok0 ? 1 : 0};
      pg8::Gemm g{WSP(u16, OFF_ZL), WSP(u16, OFF_WLORA + wsel), 256, 768, 256};
      EpiLora E{WSP(float, OFF_SW), WSP(u16, OFF_SKKA), WSP(u16, OFF_SKP), WSP(u16, OFF_SG), WSP(float, OFF_INVN), WSP(float, OFF_ZK),
                INP(float, 5) + l * 256, INP(float, 7) + l * 256, INP(float, 11) + l * 256, INP(float, 10) + l * 256};
      pg8::gemm_phase(ldsg, g, S, E, wid_k);
      __syncthreads();
    }
    }
    GSYNC();

    if (bid_is_scan(blockIdx.x)) {
      {
      PHASE_BEGIN();
      __builtin_amdgcn_s_setprio(3);
      scan_block(ldsf, WSP(u16, OFF_SR), WSP(u16, OFF_SKP), WSP(u16, OFF_SKK), WSP(u16, OFF_SKKA), WSP(u16, OFF_SV), WSP(float, OFF_SW), WSP(float, OFF_Y), bid, wid_k);
      __builtin_amdgcn_s_setprio(0);
      sub_wait(WSP(unsigned, OFF_CTL) + 4096 + (l * 2 + 1) * 64, 192u, wid_k);
      }
    } else {
      {
      PHASE_BEGIN();
      pg8::Gemm g{WSP(u16, OFF_HBUF), WSP(u16, OFF_WIN + wsel) + (size_t)1024 * 1024, 1024, 4608, 1024};
      pg8::StaticOrder S; S.init(T, 4608, 192, bid - 64);
      EpiInProj E{WSP(u16, OFF_ZRAW), WSP(u16, OFF_FQ), WSP(u16, OFF_FK), WSP(u16, OFF_FVT), WSP(u16, OFF_ZQ), WSP(u16, OFF_ZKV), WSP(u16, OFF_ZPE),
                  WSP(u16, OFF_GATES), WSP(float, OFF_FLOG), INP(float, 15) + l * 4, 1024};
      pg8::gemm_phase(ldsg, g, S, E, wid_k);
      sub_barrier(WSP(unsigned, OFF_CTL) + 4096 + (l * 2 + 0) * 64, 192u, wid_k);
      }
#pragma unroll 1
      for (int rnd = 0; rnd < 3; ++rnd) {
      PHASE_BEGIN();
      const int c = bid - 64;
      const bool do_kv = (rnd == 0) || (rnd == 1 && c < 64);
      const bool do_q = (rnd == 1 && c >= 64) || (rnd == 2 && c < 64);
      if (do_kv) {
        pg8::StaticOrder S0; S0.init(T, 1024, 256, rnd == 0 ? c : 192 + c);
        pg8::Unit u0; const bool ok0 = S0.next(0, u0);
        if (ok0) block_rstd<256>(ldsmisc, WSP(u16, OFF_ZKV), u0.pm * 256, wid_k);
        __syncthreads();
        int pm_ = u0.pm, pn_ = u0.pn; asm volatile("" : "+s"(pm_), "+s"(pn_));
        pg8::OneUnit S{pm_, pn_, ok0 ? 1 : 0};
        pg8::Gemm g{WSP(u16, OFF_ZKV), WSP(u16, OFF_WKV + wsel), 256, 1024, 256};
        EpiKv E{WSP(u16, OFF_MK), WSP(u16, OFF_MVT), ldsmisc};
        pg8::gemm_phase(ldsg, g, S, E, wid_k);
        __syncthreads();
      } else if (do_q) {
        pg8::StaticOrder S0; S0.init(T, 768, 192, rnd == 1 ? c - 64 : 128 + c);
        pg8::Unit u0; const bool ok0 = S0.next(0, u0);
        if (ok0) block_rstd<384>(ldsmisc, WSP(u16, OFF_ZQ), u0.pm * 256, wid_k);
        __syncthreads();
        int pm_ = u0.pm, pn_ = u0.pn; asm volatile("" : "+s"(pm_), "+s"(pn_));
        pg8::OneUnit S{pm_, pn_, ok0 ? 1 : 0};
        pg8::Gemm g{WSP(u16, OFF_ZQ), WSP(u16, OFF_WQ + wsel), 384, 768, 384};
        EpiQ E{WSP(u16, OFF_MQ), ldsmisc, WSP(float, OFF_COS), WSP(float, OFF_SIN)};
        pg8::gemm_phase(ldsg, g, S, E, wid_k);
        __syncthreads();
      }
      }
      {
      PHASE_BEGIN();
      const int c = bid - 64;
      if (c >= 176) {
        const int tid = otid();
        const int bh = c - 176, b = bh >> 2, h = bh & 3;
        const float* flog = WSP(float, OFF_FLOG); float* cum = WSP(float, OFF_CUM);
        float run = 0.f;
#pragma unroll
        for (int e = 0; e < 8; ++e) run += flog[((size_t)b * SEQ + tid * 8 + e) * 4 + h];
        __syncthreads();
        ldsf[tid] = run;
        __syncthreads();
        float base = 0.f;
        for (int j = 0; j < tid; ++j) base += ldsf[j];
#pragma unroll
        for (int e = 0; e < 8; ++e) { base += flog[((size_t)b * SEQ + tid * 8 + e) * 4 + h]; cum[bh * SEQ + tid * 8 + e] = base * 1.44269504f; }
        __syncthreads();
      } else if (c >= 64) {
        const int tid = otid();
        const u16* zpe = WSP(u16, OFF_ZPE); const float* costab = WSP(float, OFF_COS); const float* sintab = WSP(float, OFF_SIN); u16* mk = WSP(u16, OFF_MK);
        for (int idx = (c - 64) * NTHR + tid; idx < T * 32; idx += 112 * NTHR) {
          const int m = idx >> 5, f = idx & 31; const int b = m >> 12, s = m & 4095;
          const float x1 = bflo((unsigned)zpe[(size_t)m * 64 + f]), x2 = bflo((unsigned)zpe[(size_t)m * 64 + 32 + f]);
          const float cs = costab[idx], sn = sintab[idx];
          const u16 o1 = f2bf(x1 * cs - x2 * sn), o2 = f2bf(x1 * sn + x2 * cs);
#pragma unroll
          for (int hh = 0; hh < 4; ++hh) { u16* kp = mk + (((size_t)b * 4 + hh) * SEQ + s) * 192 + 128; kp[f] = o1; kp[32 + f] = o2; }
        }
      }
      sub_barrier(WSP(unsigned, OFF_CTL) + 4096 + (l * 2 + 1) * 64, 192u, wid_k);
      }
    }
    {
    PHASE_BEGIN();
    unsigned* ctl = WSP(unsigned, OFF_CTL);
    for (;;) {
      __syncthreads();
      if (tid == 0) ((volatile unsigned*)ldsmisc)[256] = atomicAdd(&ctl[64 + l], 1u);
      __syncthreads();
      const unsigned it = ((volatile unsigned*)ldsmisc)[256];
      if (it >= 512u) break;
      if (it < 256u) { const int qb = 15 - (int)(it >> 4), bh = it & 15; attn_item<192, 128, false>(lds, WSP(u16, OFF_MQ), WSP(u16, OFF_MK), WSP(u16, OFF_MVT), nullptr, WSP(u16, OFF_YC), 512, bh, qb, wid_k); }
      else { const unsigned i2 = it - 256u; const int qb = 15 - (int)(i2 >> 4), bh = i2 & 15; attn_item<64, 64, true>(lds, WSP(u16, OFF_FQ), WSP(u16, OFF_FK), WSP(u16, OFF_FVT), WSP(float, OFF_CUM), WSP(u16, OFF_YB), 256, bh, qb, wid_k); }
    }
    if (l < 3) { const int ln = l + 1; const size_t wseln = (ln & 1) ? (size_t)(WS_END - OFF_WIN) : (size_t)0; __syncthreads(); CONVERT_LAYER(ln, wseln); }
    }
    GSYNC();

    {
      PHASE_BEGIN();
      const float* ln_x_g = INP(float, 13); const float* ln_x_b = INP(float, 14); const float* r_k = INP(float, 12);
      const float* Ybuf = WSP(float, OFF_Y); const u16* sR = WSP(u16, OFF_SR); const u16* sKP = WSP(u16, OFF_SKP);
      const u16* sV = WSP(u16, OFF_SV); const u16* sG = WSP(u16, OFF_SG); u16* ya = WSP(u16, OFF_YA);
      const int gw = bid * 8 + wv, nw = nblk * 8;
      const int c = lane * 4;
      const float4 lg = *(const float4*)(ln_x_g + l * 256 + c), lb = *(const float4*)(ln_x_b + l * 256 + c);
      const float4 rkw = *(const float4*)(r_k + l * 256 + c);
      for (int t = gw; t < T; t += nw) {
        const float4 y = *(const float4*)(Ybuf + (size_t)t * 256 + c);
        const float mean = reduce16(y.x + y.y + y.z + y.w) * (1.f / 64.f);
        const float d0 = y.x - mean, d1 = y.y - mean, d2 = y.z - mean, d3 = y.w - mean;
        const float var = reduce16(d0 * d0 + d1 * d1 + d2 * d2 + d3 * d3) * (1.f / 64.f);
        const float rstd = rsqrtf(var + 64e-5f);
        const uint2 r = *(const uint2*)(sR + (size_t)t * 256 + c), k = *(const uint2*)(sKP + (size_t)t * 256 + c);
        const uint2 v = *(const uint2*)(sV + (size_t)t * 256 + c), g = *(const uint2*)(sG + (size_t)t * 256 + c);
        const float rk = reduce16(bflo(r.x) * bflo(k.x) * rkw.x + bfhi(r.x) * bfhi(k.x) * rkw.y + bflo(r.y) * bflo(k.y) * rkw.z + bfhi(r.y) * bfhi(k.y) * rkw.w);
        f32x4 o;
        o[0] = (d0 * rstd * lg.x + lb.x + rk * bflo(v.x)) * bflo(g.x);
        o[1] = (d1 * rstd * lg.y + lb.y + rk * bfhi(v.x)) * bfhi(g.x);
        o[2] = (d2 * rstd * lg.z + lb.z + rk * bflo(v.y)) * bflo(g.y);
        o[3] = (d3 * rstd * lg.w + lb.w + rk * bfhi(v.y)) * bfhi(g.y);
        *(uint2*)(ya + (size_t)t * 256 + c) = pack4(o);
      }
    }
    GSYNC();

    {
    PHASE_BEGIN();
    pg8::StaticOrder S0; S0.init(T, 1024, nblk, bid);
    pg8::Unit u0; const bool ok0 = S0.next(0, u0);
    int pm_ = u0.pm, pn_ = u0.pn; asm volatile("" : "+s"(pm_), "+s"(pn_));
    pg8::OneUnit S{pm_, pn_, ok0 ? 1 : 0};
    const u16* gates = WSP(u16, OFF_GATES); float* tmp = WSP(float, OFF_TMP); u16* merged = WSP(u16, OFF_MERGED);
    { pg8::Gemm g{WSP(u16, OFF_YC), WSP(u16, OFF_WC + wsel), 512, 1024, 512}; EpiMerge<0> E{tmp, merged, gates + 2048}; pg8::gemm_phase(ldsg, g, S, E, wid_k); }
    asm volatile("s_waitcnt vmcnt(0)" ::: "memory");
    { pg8::Gemm g{WSP(u16, OFF_YA), WSP(u16, OFF_WA + wsel), 256, 1024, 256}; EpiMerge<1> E{tmp, merged, gates}; pg8::gemm_phase(ldsg, g, S, E, wid_k); }
    asm volatile("s_waitcnt vmcnt(0)" ::: "memory");
    { pg8::Gemm g{WSP(u16, OFF_YB), WSP(u16, OFF_WB + wsel), 256, 1024, 256}; EpiMerge<2> E{tmp, merged, gates + 1024}; pg8::gemm_phase(ldsg, g, S, E, wid_k); }
    }
    GSYNC();

    {
    PHASE_BEGIN();
    pg8::Gemm g{WSP(u16, OFF_MERGED), WSP(u16, OFF_WOUT + wsel), 1024, 1024, 1024};
    pg8::StaticOrder S; S.init(T, 1024, nblk, bid);
    EpiStore<0> E{WSP(u16, OFF_TBUF), 1024};
    pg8::gemm_phase(ldsg, g, S, E, wid_k);
    }
    GSYNC();

    {
    PHASE_BEGIN();
    const float* modl = WSP(float, OFF_MOD) + (size_t)l * 4 * 6144;
    rowwise_phase(OUTP(), OUTP(), WSP(u16, OFF_TBUF), modl + 2048, INP(float, 27) + l * 1024, INP(float, 28) + l * 1024, modl + 4096, modl + 3072, WSP(u16, OFF_HBUF), bid, nblk, wid_k);
    }
    GSYNC();

    {
    PHASE_BEGIN();
    pg8::Gemm g{WSP(u16, OFF_HBUF), WSP(u16, OFF_WUP + wsel), 1024, 4096, 1024};
    pg8::StaticOrder S; S.init(T, 4096, nblk, bid);
    EpiStore<1> E{WSP(u16, OFF_UBUF), 4096};
    pg8::gemm_phase(ldsg, g, S, E, wid_k);
    }
    GSYNC();

    {
    PHASE_BEGIN();
    pg8::Gemm g{WSP(u16, OFF_UBUF), WSP(u16, OFF_WDN + wsel), 4096, 1024, 4096};
    pg8::StaticOrder S; S.init(T, 1024, nblk, bid);
    EpiStore<0> E{WSP(u16, OFF_TBUF), 1024};
    pg8::gemm_phase(ldsg, g, S, E, wid_k);
    }
    GSYNC();
  }
  {
  PHASE_BEGIN();
  rowwise_phase(OUTP(), OUTP(), WSP(u16, OFF_TBUF), WSP(float, OFF_MOD) + (size_t)3 * 4 * 6144 + 5120, INP(float, 29) + 3 * 1024, nullptr, nullptr, nullptr, nullptr, bid, nblk, wid_k);
  }
}

extern "C" void kernel_launch(void* const* d_in, const int* in_sizes, int n_in, void* d_out, int out_size, void* d_ws, size_t ws_size,
                              hipStream_t stream) {
  static int grid_blocks = 0;
  if (!grid_blocks) {
    int dev = 0, cus = 0, per_cu = 0;
    (void)hipGetDevice(&dev);
    (void)hipDeviceGetAttribute(&cus, hipDeviceAttributeMultiprocessorCount, dev);
    (void)hipFuncSetAttribute((const void*)fwd_kernel, hipFuncAttributeMaxDynamicSharedMemorySize, LDS_BYTES);
    (void)hipOccupancyMaxActiveBlocksPerMultiprocessor(&per_cu, (const void*)fwd_kernel, NTHR, LDS_BYTES);
    if (per_cu < 1) fprintf(stderr, "kernel_launch: occupancy query says %d workgroups per CU\n", per_cu);
    grid_blocks = 256;
    if (cus != 256) fprintf(stderr, "kernel_launch: device has %d CUs, kernel is laid out for 256\n", cus);
    if (ws_size < WS_END + (OFF_ACT - OFF_WIN)) fprintf(stderr, "kernel_launch: workspace too small: %zu < %zu\n", ws_size, (size_t)WS_END);
  }
  (void)hipMemsetAsync((char*)d_ws + OFF_CTL, 0, 65536, stream);
  Params p{};
  for (int i = 0; i < 32; ++i) p.in[i] = d_in[i];
  p.out = (float*)d_out; p.ws = (unsigned char*)d_ws;
  void* args[] = {&p};
  hipError_t e = hipLaunchCooperativeKernel((const void*)fwd_kernel, dim3(grid_blocks), dim3(NTHR), args, LDS_BYTES, stream);
  if (e != hipSuccess) fprintf(stderr, "cooperative launch failed: %s (grid %d)\n", hipGetErrorString(e), grid_blocks);
}
```
